# Optimizing an MI355X kernel written in HIP

```python
import math
import jax, jax.numpy as jnp
from jax import lax
import numpy as np

D_MODEL = 1024
BATCH = 4
SEQ = 8192
DEPTH = 2

HEAD_DIM = 64
CONV_CH = 256
CONV_K = 31
SC_CH = 256
SC_K = 3
SWA_Q_HEADS = 4
SWA_KV_HEADS = 2
WINDOW = 128
BLOCK = 128
FOX_HEADS = 4
N_BUCKETS = 32
MAX_DISTANCE = 128
D_FF = 2816
N_BRANCH = 4
EPS = 1e-6
NEG_INF = -1e30

SWA_COLS = (SWA_Q_HEADS + 2 * SWA_KV_HEADS) * HEAD_DIM
FOX_COLS = 3 * FOX_HEADS * HEAD_DIM + FOX_HEADS
_SIZES = (CONV_CH, CONV_CH,
          SC_CH, SC_CH, SC_CH,
          SWA_Q_HEADS * HEAD_DIM, SWA_KV_HEADS * HEAD_DIM, SWA_KV_HEADS * HEAD_DIM,
          FOX_HEADS * HEAD_DIM, FOX_HEADS * HEAD_DIM, FOX_HEADS * HEAD_DIM, FOX_HEADS,
          N_BRANCH * D_MODEL)
SPLITS = tuple(int(s) for s in np.cumsum(_SIZES)[:-1])
IN_COLS = int(sum(_SIZES))

kernel_name = "hybrid_gated_conformer_shortconv_swa_fox"


def _rmsnorm(x, g):
    xf = x.astype(jnp.float32)
    y = xf * lax.rsqrt(jnp.mean(xf * xf, axis=-1, keepdims=True) + EPS)
    return (y * g.astype(jnp.float32)).astype(x.dtype)


def _layernorm(x, g, b):
    xf = x.astype(jnp.float32)
    mu = jnp.mean(xf, axis=-1, keepdims=True)
    var = jnp.mean(jnp.square(xf - mu), axis=-1, keepdims=True)
    y = (xf - mu) * lax.rsqrt(var + EPS)
    return (y * g.astype(jnp.float32) + b.astype(jnp.float32)).astype(x.dtype)


def _swiglu(x, w_gate, w_up, w_down):
    return (jax.nn.silu(x @ w_gate) * (x @ w_up)) @ w_down


def _causal_depthwise_conv(x, w):
    k = w.shape[0]
    return lax.conv_general_dilated(
        x, w[:, None, :].astype(x.dtype), window_strides=(1,), padding=[(k - 1, 0)],
        dimension_numbers=("NWC", "WIO", "NWC"), feature_group_count=x.shape[-1])


def _t5_bucket(dist):
    max_exact = N_BUCKETS // 2
    d = jnp.maximum(dist, 1).astype(jnp.float32)
    large = max_exact + (jnp.log(d / max_exact) / math.log(MAX_DISTANCE / max_exact)
                         * (N_BUCKETS - max_exact)).astype(jnp.int32)
    large = jnp.minimum(large, N_BUCKETS - 1)
    return jnp.where(dist < max_exact, dist, large)


def _sliding_window_attention(q, k, v, sink, rel_bias):
    b, t, hq, dh = q.shape
    hkv = k.shape[2]
    grp = hq // hkv
    nb = t // BLOCK
    qb = q.reshape(b, nb, BLOCK, hkv, grp, dh)
    kb = k.reshape(b, nb, BLOCK, hkv, dh)
    vb = v.reshape(b, nb, BLOCK, hkv, dh)
    pad = ((0, 0), (1, 0), (0, 0), (0, 0), (0, 0))
    kk = jnp.concatenate([jnp.pad(kb, pad)[:, :-1], kb], axis=2)
    vv = jnp.concatenate([jnp.pad(vb, pad)[:, :-1], vb], axis=2)
    s = jnp.einsum("bnqhgd,bnkhd->bnhgqk", qb, kk,
                   preferred_element_type=jnp.float32) * (dh ** -0.5)
    qi = jnp.arange(BLOCK)[:, None] + BLOCK
    ki = jnp.arange(2 * BLOCK)[None, :]
    dist = qi - ki
    local_ok = (dist >= 0) & (dist < WINDOW)
    blk_ok = (jnp.arange(nb)[:, None, None] > 0) | (ki[None] >= BLOCK)
    mask = local_ok[None] & blk_ok
    bias = rel_bias[_t5_bucket(jnp.maximum(dist, 0))]
    bias = bias.transpose(2, 0, 1).reshape(hkv, grp, BLOCK, 2 * BLOCK).astype(jnp.float32)
    s = jnp.where(mask[None, :, None, None], s + bias, NEG_INF)
    sk = sink.astype(jnp.float32).reshape(hkv, grp)[:, :, None, None]
    m = jnp.maximum(jnp.max(s, axis=-1, keepdims=True), sk)
    p = jnp.exp(s - m)
    p = p / (jnp.sum(p, axis=-1, keepdims=True) + jnp.exp(sk - m))
    o = jnp.einsum("bnhgqk,bnkhd->bnqhgd", p.astype(v.dtype), vv)
    return o.reshape(b, t, hq * dh)


def _forgetting_attention(q, k, v, log_f):
    b, t, h, dh = q.shape
    nb = t // BLOCK
    cum = jnp.cumsum(log_f, axis=1)
    cum_k = cum.transpose(0, 2, 1)
    qb = q.reshape(b, nb, BLOCK, h, dh).transpose(1, 0, 2, 3, 4)
    cq = cum.reshape(b, nb, BLOCK, h).transpose(1, 0, 3, 2)
    kpos = jnp.arange(t)

    def one_block(args):
        q_blk, c_blk, bi = args
        s = jnp.einsum("bqhd,bkhd->bhqk", q_blk, k,
                       preferred_element_type=jnp.float32) * (dh ** -0.5)
        s = s + (c_blk[..., :, None] - cum_k[:, :, None, :])
        qpos = bi * BLOCK + jnp.arange(BLOCK)
        s = jnp.where(kpos[None, :] <= qpos[:, None], s, NEG_INF)
        p = jax.nn.softmax(s, axis=-1)
        return jnp.einsum("bhqk,bkhd->bqhd", p.astype(v.dtype), v)

    o = lax.map(one_block, (qb, cq, jnp.arange(nb)))
    return o.transpose(1, 0, 2, 3, 4).reshape(b, t, h * dh)


def _normal(k, shape, scale):
    return scale * jax.random.normal(k, shape, jnp.float32)


def setup_inputs(seed: int = 0) -> dict:
    key = jax.random.key(seed)
    ks = jax.random.split(key, 32)
    L, D = DEPTH, D_MODEL
    return {
        "x": _normal(ks[0], (BATCH, SEQ, D), 1.0),
        "rel_bias": _normal(ks[1], (N_BUCKETS, SWA_Q_HEADS), 0.5),
        "ffn1_norm": 1.0 + _normal(ks[2], (L, D), 0.05),
        "ffn1_w_gate": _normal(ks[3], (L, D, D_FF), D ** -0.5),
        "ffn1_w_up": _normal(ks[4], (L, D, D_FF), D ** -0.5),
        "ffn1_w_down": _normal(ks[5], (L, D_FF, D), D_FF ** -0.5),
        "mix_norm": 1.0 + _normal(ks[6], (L, D), 0.05),
        "w_in": _normal(ks[7], (L, D, IN_COLS), D ** -0.5),
        "b_forget": 3.0 + _normal(ks[8], (L, FOX_HEADS), 0.5),
        "conf_dw": _normal(ks[9], (L, CONV_K, CONV_CH), CONV_K ** -0.5),
        "conf_dw_b": _normal(ks[10], (L, CONV_CH), 0.02),
        "conf_ln_g": 1.0 + _normal(ks[11], (L, CONV_CH), 0.05),
        "conf_ln_b": _normal(ks[12], (L, CONV_CH), 0.02),
        "conf_w_out": _normal(ks[13], (L, CONV_CH, D), CONV_CH ** -0.5),
        "sc_conv": _normal(ks[14], (L, SC_K, SC_CH), SC_K ** -0.5),
        "sc_w_out": _normal(ks[15], (L, SC_CH, D), SC_CH ** -0.5),
        "swa_q_norm": 1.0 + _normal(ks[16], (L, HEAD_DIM), 0.05),
        "swa_k_norm": 1.0 + _normal(ks[17], (L, HEAD_DIM), 0.05),
        "swa_sink": _normal(ks[18], (L, SWA_Q_HEADS), 0.5),
        "swa_w_o": _normal(ks[19], (L, SWA_Q_HEADS * HEAD_DIM, D), (SWA_Q_HEADS * HEAD_DIM) ** -0.5),
        "fox_q_norm": 1.0 + _normal(ks[20], (L, HEAD_DIM), 0.05),
        "fox_k_norm": 1.0 + _normal(ks[21], (L, HEAD_DIM), 0.05),
        "fox_w_o": _normal(ks[22], (L, FOX_HEADS * HEAD_DIM, D), (FOX_HEADS * HEAD_DIM) ** -0.5),
        "w_out": _normal(ks[23], (L, D, D), D ** -0.5),
        "ffn2_norm": 1.0 + _normal(ks[24], (L, D), 0.05),
        "ffn2_w_gate": _normal(ks[25], (L, D, D_FF), D ** -0.5),
        "ffn2_w_up": _normal(ks[26], (L, D, D_FF), D ** -0.5),
        "ffn2_w_down": _normal(ks[27], (L, D_FF, D), D_FF ** -0.5),
    }


def reference(x, rel_bias, ffn1_norm, ffn1_w_gate, ffn1_w_up, ffn1_w_down, mix_norm, w_in,
              b_forget, conf_dw, conf_dw_b, conf_ln_g, conf_ln_b, conf_w_out, sc_conv, sc_w_out,
              swa_q_norm, swa_k_norm, swa_sink, swa_w_o, fox_q_norm, fox_k_norm, fox_w_o, w_out,
              ffn2_norm, ffn2_w_gate, ffn2_w_up, ffn2_w_down):
    bsz, t = x.shape[0], x.shape[1]
    for l in range(DEPTH):
        x = x + 0.5 * _swiglu(_rmsnorm(x, ffn1_norm[l]), ffn1_w_gate[l], ffn1_w_up[l], ffn1_w_down[l])

        h = _rmsnorm(x, mix_norm[l])
        z = h @ w_in[l]
        (c_a, c_b, s_b, s_c, s_x, a_q, a_k, a_v,
         f_q, f_k, f_v, f_f, z_gate) = jnp.split(z, SPLITS, axis=-1)

        u = c_a * jax.nn.sigmoid(c_b)
        u = _causal_depthwise_conv(u, conf_dw[l]) + conf_dw_b[l]
        u = jax.nn.silu(_layernorm(u, conf_ln_g[l], conf_ln_b[l]))
        p_conf = u @ conf_w_out[l]

        p_sc = (s_b * _causal_depthwise_conv(s_c * s_x, sc_conv[l])) @ sc_w_out[l]

        q = _rmsnorm(a_q.reshape(bsz, t, SWA_Q_HEADS, HEAD_DIM), swa_q_norm[l])
        k = _rmsnorm(a_k.reshape(bsz, t, SWA_KV_HEADS, HEAD_DIM), swa_k_norm[l])
        v = a_v.reshape(bsz, t, SWA_KV_HEADS, HEAD_DIM)
        p_swa = _sliding_window_attention(q, k, v, swa_sink[l], rel_bias) @ swa_w_o[l]

        q2 = _rmsnorm(f_q.reshape(bsz, t, FOX_HEADS, HEAD_DIM), fox_q_norm[l])
        k2 = _rmsnorm(f_k.reshape(bsz, t, FOX_HEADS, HEAD_DIM), fox_k_norm[l])
        v2 = f_v.reshape(bsz, t, FOX_HEADS, HEAD_DIM)
        log_f = jax.nn.log_sigmoid(f_f.astype(jnp.float32) + b_forget[l].astype(jnp.float32))
        p_fox = _forgetting_attention(q2, k2, v2, log_f) @ fox_w_o[l]

        g = jax.nn.sigmoid(z_gate).reshape(bsz, t, N_BRANCH, D_MODEL)
        merged = (g[:, :, 0] * p_conf + g[:, :, 1] * p_sc
                  + g[:, :, 2] * p_swa + g[:, :, 3] * p_fox)
        x = x + merged @ w_out[l]

        x = x + 0.5 * _swiglu(_rmsnorm(x, ffn2_norm[l]), ffn2_w_gate[l], ffn2_w_up[l], ffn2_w_down[l])
    return x
```

```cpp
#include <hip/hip_runtime.h>
#include <hip/hip_cooperative_groups.h>
#include <cstdio>
#include <cstdint>
constexpr int D = 1024, BATCH = 4, SEQ = 8192, M = BATCH * SEQ, DFF = 2816, INC = 6660, NWIN = 6656;
constexpr float EPS = 1e-6f, LOG2E = 1.4426950408889634f;
constexpr int NWAVES = 8, NTHR = 512;
constexpr int LDS_BYTES = 149504;
constexpr int LDS_RS = 131072 + 1024;
constexpr size_t MiB = 1u << 20;
constexpr size_t WS_CTL = 0, CTL_ZERO_BYTES = 2 * MiB;
constexpr size_t WS_SS = 1 * MiB;
constexpr size_t WS_LF = 2 * MiB, WS_FC = 2 * MiB + 512 * 1024;
constexpr size_t WS_CONST = 3 * MiB;
constexpr size_t WS_W = 4 * MiB;
constexpr size_t W_1GU = 0, W_1D = 11 * MiB, W_IN = 16 * MiB + 512 * 1024, W_BR = W_IN + 13 * MiB, W_OUT = W_BR + 2 * MiB, W_2GU = W_OUT + 2 * MiB, W_2D = W_2GU + 11 * MiB;
constexpr size_t WS_XB = 54 * MiB;
constexpr size_t WS_R1 = 118 * MiB;
constexpr size_t R_U = 0, R_SCX = 16 * MiB, R_SB = 32 * MiB, R_AQ = 48 * MiB, R_AK = 64 * MiB, R_AVT = 72 * MiB, R_FQ = 80 * MiB, R_FK = 96 * MiB, R_FV = 112 * MiB;
constexpr size_t WS_G = 246 * MiB;
constexpr size_t WS_SSP = 502 * MiB;
constexpr size_t WS_END = 504 * MiB;
static_assert(W_2D + (size_t)1024 * 2816 * 2 <= 50 * MiB, "weights map");
#ifndef FOX_ROWMAJOR_V
#define FOX_ROWMAJOR_V 1
#endif
#ifndef MERGE_4PASS
#define MERGE_4PASS 0
#endif
#define GAS __attribute__((address_space(1)))
#ifndef DYNQ
#define DYNQ 1
#endif
namespace pg8 {
#define PG8_LAS __attribute__((address_space(3)))
typedef unsigned short bf16_t;
typedef short bf16x8 __attribute__((ext_vector_type(8)));
typedef float f32x4 __attribute__((ext_vector_type(4)));
typedef unsigned u32x4 __attribute__((ext_vector_type(4)));
constexpr int BM = 256, BK = 64, HALF = 128, HTB = HALF * BK * 2  , STAGE_BYTES = 8 * HTB, NXCD = 8, WGM = 8;

__host__ __device__ __forceinline__ int lds_byte(int r, int c) { const int st = (r >> 4) * 2 + (c >> 5), rr = r & 15, cc = c & 31, ob = rr * 64 + cc * 2; return st * 1024 + (ob ^ (((ob >> 9) & 1) << 5)); }
__host__ __device__ __forceinline__ void stage_rc(int b, int& R, int& C) { const int st = b / 1024, sb = b % 1024, swz = sb ^ (((sb >> 9) & 1) << 5); R = (st >> 1) * 16 + swz / 64; C = (st & 1) * 32 + (swz % 64) / 2; }
__host__ __device__ __forceinline__ int perm32(int rho) { const int n = rho >> 4, i = rho & 15; return 8 * (i >> 2) + 4 * n + (i & 3); }

struct Unit { int pm, pn; };
struct Gemm { const bf16_t* A; const bf16_t* Bt; int M, N, K; };

struct StaticOrder {
    int nM, nN, nwg, G, c;
    __host__ __device__ void init(int M, int N, int G_, int c_) { nM = M / BM; nN = N / BM; nwg = nM * nN; G = G_; c = c_; }
    __host__ __device__ bool next(int i, Unit& u) const {
        const long L = (long)i * G + c; if (L >= nwg) return false;
        int wgid = (int)L; { const int q = nwg / NXCD, r = nwg % NXCD, xcd = wgid % NXCD, off = wgid / NXCD; wgid = (xcd < r ? xcd * (q + 1) : r * (q + 1) + (xcd - r) * q) + off; }
        const int nig = WGM * nN, gid = wgid / nig, fm = gid * WGM, gsz = (nM - fm) < WGM ? (nM - fm) : WGM;
        u.pm = fm + ((wgid % nig) % gsz); u.pn = (wgid % nig) / gsz; return true;
    }
    __device__ __forceinline__ void a_ready(const Unit&) const {}
    __device__ __forceinline__ void done(const Unit&) const {}
};

__device__ __forceinline__ unsigned cvt_pk_bf16(float lo, float hi) { unsigned r; asm volatile("v_cvt_pk_bf16_f32 %0, %1, %2" : "=v"(r) : "v"(lo), "v"(hi)); return r; }
typedef float f32x2 __attribute__((ext_vector_type(2)));
constexpr int P_D = 1024, P_SEQ = 8192, P_DFF = 2816;
constexpr float P_EPS = 1e-6f;
constexpr float P_QSCALE = 0.125f * 1.4426950408889634f;
__device__ __forceinline__ float fsigmoid(float x) { return __builtin_amdgcn_rcpf(1.0f + __expf(-x)); }
__device__ __forceinline__ float fsilu(float x) { return x * fsigmoid(x); }
__device__ __forceinline__ float rs_row(const float* ssp, int row) { const f32x4* q = (const f32x4*)(ssp + (size_t)row * 16); const f32x4 a = q[0], b = q[1], c = q[2], d = q[3];
    const float s = (((a[0] + a[1]) + (a[2] + a[3])) + ((b[0] + b[1]) + (b[2] + b[3]))) + (((c[0] + c[1]) + (c[2] + c[3])) + ((d[0] + d[1]) + (d[2] + d[3])));
    return rsqrtf(s * (1.0f / 1024.0f) + P_EPS); }
template <int NB> __device__ __forceinline__ void rs_rows8(const float* ssp, int row0, float (&rs)[8]) {
#pragma unroll
    for (int b0 = 0; b0 < 8; b0 += NB) {
        f32x4 q[NB][4];
#pragma unroll
        for (int j = 0; j < NB; ++j) { const int r = b0 + j; const f32x4* p = (const f32x4*)(ssp + (size_t)(row0 + (r >> 2) * HALF + (r & 3) * 16) * 16);
#pragma unroll
            for (int k = 0; k < 4; ++k) q[j][k] = p[k]; }
#pragma unroll
        for (int j = 0; j < NB; ++j) { const f32x4 a = q[j][0], b = q[j][1], c = q[j][2], d = q[j][3];
            const float s = (((a[0] + a[1]) + (a[2] + a[3])) + ((b[0] + b[1]) + (b[2] + b[3]))) + (((c[0] + c[1]) + (c[2] + c[3])) + ((d[0] + d[1]) + (d[2] + d[3])));
            rs[b0 + j] = rsqrtf(s * (1.0f / 1024.0f) + P_EPS); }
        asm volatile("" ::: "memory");
    }
}
__device__ __forceinline__ void rs_rows8w(const float* ssp, int rowbase  , int fr, int fq, float (&rs)[8]) {
    const int lane = fr + 16 * fq; f32x4 q[2][4]; float r[2];
#pragma unroll
    for (int h = 0; h < 2; ++h) { const f32x4* p = (const f32x4*)(ssp + (size_t)(rowbase + h * HALF + lane) * 16);
#pragma unroll
        for (int k = 0; k < 4; ++k) q[h][k] = p[k]; }
#pragma unroll
    for (int h = 0; h < 2; ++h) { const f32x4 a = q[h][0], b = q[h][1], c = q[h][2], d = q[h][3];
        const float s = (((a[0] + a[1]) + (a[2] + a[3])) + ((b[0] + b[1]) + (b[2] + b[3]))) + (((c[0] + c[1]) + (c[2] + c[3])) + ((d[0] + d[1]) + (d[2] + d[3])));
        r[h] = rsqrtf(s * (1.0f / 1024.0f) + P_EPS); }
#pragma unroll
    for (int ai = 0; ai < 2; ++ai)
#pragma unroll
        for (int m = 0; m < 4; ++m) rs[ai * 4 + m] = __shfl(r[ai], 16 * m + fr);
    asm volatile("" ::: "memory");
}
__device__ __forceinline__ void rs_rows8l(PG8_LAS const float* grp  , int fr, int fq, float (&rs)[8]) {
    const int lane = fr + 16 * fq; f32x4 q[2][4]; float r[2];
#pragma unroll
    for (int h = 0; h < 2; ++h) { PG8_LAS const f32x4* p = (PG8_LAS const f32x4*)(grp + (h * 64 + lane) * 16);
#pragma unroll
        for (int k = 0; k < 4; ++k) q[h][k] = p[k]; }
#pragma unroll
    for (int h = 0; h < 2; ++h) { const f32x4 a = q[h][0], b = q[h][1], c = q[h][2], d = q[h][3];
        const float s = (((a[0] + a[1]) + (a[2] + a[3])) + ((b[0] + b[1]) + (b[2] + b[3]))) + (((c[0] + c[1]) + (c[2] + c[3])) + ((d[0] + d[1]) + (d[2] + d[3])));
        r[h] = rsqrtf(s * (1.0f / 1024.0f) + P_EPS); }
#pragma unroll
    for (int ai = 0; ai < 2; ++ai)
#pragma unroll
        for (int m = 0; m < 4; ++m) rs[ai * 4 + m] = __shfl(r[ai], 16 * m + fr);
}
__device__ __forceinline__ void store8(bf16_t* p, const f32x4 a, const f32x4 b) {
    u32x4 w; w.x = cvt_pk_bf16(a[0], a[1]); w.y = cvt_pk_bf16(a[2], a[3]); w.z = cvt_pk_bf16(b[0], b[1]); w.w = cvt_pk_bf16(b[2], b[3]);
    *(GAS u32x4*)p = w;
}
__device__ __forceinline__ f32x4 bf_lo4(unsigned a, unsigned b) { return (f32x4){__uint_as_float(a << 16), __uint_as_float(a & 0xffff0000u), __uint_as_float(b << 16), __uint_as_float(b & 0xffff0000u)}; }
__device__ __forceinline__ unsigned short f2bf1(float f) { unsigned u = __float_as_uint(f); return (unsigned short)((u + 0x7fffu + ((u >> 16) & 1u)) >> 16); }

struct EpiSwiglu {
    static constexpr bool PERM = true, AFTER_DRAIN = false, KEEP = false, PREFETCH = false, RSDMA = true;
    unsigned char* ws; const float* ss; PG8_LAS const float* rsl;
    __device__ __forceinline__ const float* rs_src() const { return ss; }
    __device__ __forceinline__ void operator()(const f32x4 (&acc)[2][2][4][2], const Unit& u, int wr, int wc, int fr, int fq) const {
        const int row0 = u.pm * BM + wr * 64 + fr, col = u.pn * 128 + wc * 32 + 8 * fq; bf16_t* act = (bf16_t*)(ws + WS_G);
        float rsv[8]; rs_rows8l(rsl + wr * 2048, fr, fq, rsv);
#pragma unroll
        for (int ai = 0; ai < 2; ++ai)
#pragma unroll
            for (int m = 0; m < 4; ++m) {
                const int row = row0 + ai * HALF + m * 16; const float rs = rsv[ai * 4 + m], rsg = rs * 1.4426950408889634f, rsu = rs * 0.6931471805599453f;
                f32x4 o[2];
#pragma unroll
                for (int n = 0; n < 2; ++n) {
                    const f32x4 g2 = acc[ai][0][m][n] * rsg, u2 = acc[ai][1][m][n] * rsu;
                    f32x4 ex;
#pragma unroll
                    for (int i = 0; i < 4; ++i) ex[i] = __builtin_amdgcn_exp2f(fminf(-g2[i], 28.853900817779268f));
                    ex = ex + 1.0f;
                    const float a = ex[0] * ex[1], b = ex[2] * ex[3], r = __builtin_amdgcn_rcpf(a * b), ra = r * b, rb = r * a;
                    const f32x4 inv = (f32x4){ex[1], ex[0], ex[3], ex[2]} * (f32x4){ra, ra, rb, rb};
                    o[n] = (g2 * inv) * u2; }
                store8(act + (size_t)row * P_DFF + col, o[0], o[1]);
                asm volatile("" ::: "memory");
            }
    }
};
struct EpiResid {
    static constexpr bool PERM = true, AFTER_DRAIN = false, KEEP = false, PREFETCH = false, RSDMA = false;
    const bf16_t* xin; bf16_t* xb; bf16_t* xs; float* xout; float* ssn; float scale;
    __device__ __forceinline__ void operator()(const f32x4 (&acc)[2][2][4][2], const Unit& u, int wr, int wc, int fr, int fq) const {
        const int row0 = u.pm * BM + wr * 64 + fr, col0 = u.pn * BM + wc * 32 + 8 * fq;
        u32x4 xv[4][2][2];
#define RESID_LOAD(q) do { _Pragma("unroll") for (int mm = 0; mm < 2; ++mm) _Pragma("unroll") for (int bj = 0; bj < 2; ++bj) \
            xv[q][mm][bj] = *(const GAS u32x4*)(xin + (size_t)(row0 + ((q) >> 1) * HALF + (((q) & 1) * 2 + mm) * 16) * P_D + col0 + bj * HALF); } while (0)
        RESID_LOAD(0); RESID_LOAD(1); RESID_LOAD(2);
#pragma unroll
        for (int q = 0; q < 4; ++q) {
            if (q == 1) RESID_LOAD(3);
            const int ai = q >> 1;
#pragma unroll
            for (int mm = 0; mm < 2; ++mm) {
                const int m = (q & 1) * 2 + mm, row = row0 + ai * HALF + m * 16; float part = 0.f;
#pragma unroll
                for (int bj = 0; bj < 2; ++bj) {
                    const size_t off = (size_t)row * P_D + col0 + bj * HALF;
                    const f32x4 n0 = bf_lo4(xv[q][mm][bj].x, xv[q][mm][bj].y) + acc[ai][bj][m][0] * scale, n1 = bf_lo4(xv[q][mm][bj].z, xv[q][mm][bj].w) + acc[ai][bj][m][1] * scale;
                    if (xout) { *(GAS f32x4*)(xout + off) = n0; *(GAS f32x4*)(xout + off + 4) = n1; }
                    if (xb) store8(xb + off, n0, n1);
                    if (xs) store8(xs + off, n0, n1);
                    part += (n0[0] * n0[0] + n0[1] * n0[1]) + (n0[2] * n0[2] + n0[3] * n0[3]) + (n1[0] * n1[0] + n1[1] * n1[1]) + (n1[2] * n1[2] + n1[3] * n1[3]);
                }
                part += __shfl_xor(part, 16); part += __shfl_xor(part, 32);
                if (ssn && fq == 0) *(GAS float*)(ssn + (size_t)row * 16 + u.pn * 4 + wc) = part;
            }
        }
#undef RESID_LOAD
        asm volatile("" ::: "memory");
    }
};
struct EpiWin {
    static constexpr bool PERM = true, AFTER_DRAIN = false, KEEP = false, PREFETCH = false, RSDMA = true;
    unsigned char* ws; const float* ss; int l; PG8_LAS const float* rsl;
    __device__ __forceinline__ const float* rs_src() const { return ss; }
    __device__ __forceinline__ void operator()(const f32x4 (&acc)[2][2][4][2], const Unit& u, int wr, int wc, int fr, int fq) const {
        const int pn = u.pn, row0 = u.pm * BM + wr * 64 + fr;
        float rsv[8]; rs_rows8l(rsl + wr * 2048, fr, fq, rsv);
        unsigned char* r1 = ws + WS_R1;
        bf16_t *U = (bf16_t*)(r1 + R_U), *SCX = (bf16_t*)(r1 + R_SCX), *SB = (bf16_t*)(r1 + R_SB), *AQ = (bf16_t*)(r1 + R_AQ), *AK = (bf16_t*)(r1 + R_AK), *AVt = (bf16_t*)(r1 + R_AVT),
               *FQ = (bf16_t*)(r1 + R_FQ), *FK = (bf16_t*)(r1 + R_FK), *FV = FOX_ROWMAJOR_V ? (bf16_t*)(r1 + R_FV) : nullptr, *FVt = FOX_ROWMAJOR_V ? nullptr : (bf16_t*)(r1 + R_FV), *G = (bf16_t*)(ws + WS_G);
        const float* cw = (const float*)(ws + WS_CONST) + l * 256; const float *gq_swa = cw, *gk_swa = cw + 64, *gq_fox = cw + 128, *gk_fox = cw + 192;
        if (pn < 4) {
            bf16_t* dst = pn < 2 ? U : SCX; const int cb = (pn & 1) * 128 + wc * 32 + 8 * fq;
#pragma unroll
            for (int ai = 0; ai < 2; ++ai)
#pragma unroll
                for (int m = 0; m < 4; ++m) {
                    const int row = row0 + ai * HALF + m * 16; const float rs = rsv[ai * 4 + m];
                    f32x4 o[2];
#pragma unroll
                    for (int n = 0; n < 2; ++n) { const f32x4 a = acc[ai][0][m][n] * rs, b = acc[ai][1][m][n] * rs;
#pragma unroll
                        for (int i = 0; i < 4; ++i) o[n][i] = pn < 2 ? a[i] * fsigmoid(b[i]) : a[i] * b[i]; }
                    store8(dst + (size_t)row * 256 + cb, o[0], o[1]);
                    asm volatile("" ::: "memory");
                }
        } else if (pn == 4) {
#pragma unroll
            for (int ai = 0; ai < 2; ++ai)
#pragma unroll
                for (int m = 0; m < 4; ++m) {
                    const int row = row0 + ai * HALF + m * 16; const float rs = rsv[ai * 4 + m];
#pragma unroll
                    for (int bj = 0; bj < 2; ++bj) store8(SB + (size_t)row * 256 + bj * HALF + wc * 32 + 8 * fq, acc[ai][bj][m][0] * rs, acc[ai][bj][m][1] * rs);
                    asm volatile("" ::: "memory");
                }
        } else if (pn >= 10) {
            const int c0 = 64 * (pn - 10) + 16 * wc + 4 * fq;
#pragma unroll
            for (int ai = 0; ai < 2; ++ai)
#pragma unroll
                for (int m = 0; m < 4; ++m) {
                    const int row = row0 + ai * HALF + m * 16; const float rs = rsv[ai * 4 + m];
                    const float rsl = -rs * 1.4426950408889634f;
                    f32x4 e0 = acc[ai][0][m][0] * rsl, e1 = acc[ai][0][m][1] * rsl, e2 = acc[ai][1][m][0] * rsl, e3 = acc[ai][1][m][1] * rsl;
#pragma unroll
                    for (int i = 0; i < 4; ++i) { e0[i] = __builtin_amdgcn_exp2f(fminf(e0[i], 28.853900817779268f)); e1[i] = __builtin_amdgcn_exp2f(fminf(e1[i], 28.853900817779268f));
                                                  e2[i] = __builtin_amdgcn_exp2f(fminf(e2[i], 28.853900817779268f)); e3[i] = __builtin_amdgcn_exp2f(fminf(e3[i], 28.853900817779268f)); }
                    e0 = e0 + 1.0f; e1 = e1 + 1.0f; e2 = e2 + 1.0f; e3 = e3 + 1.0f;
                    const f32x4 a = e0 * e1, b = e2 * e3, ab = a * b; f32x4 r;
#pragma unroll
                    for (int i = 0; i < 4; ++i) r[i] = __builtin_amdgcn_rcpf(ab[i]);
                    const f32x4 ra = r * b, rb = r * a;
                    const f32x4 s0 = (ra * e1) * e1, s1 = (ra * e0) * e2, s2 = (rb * e3) * e3, s3 = rb * e2;
                    bf16_t* gp = G + (size_t)row * 4096 + c0;
                    *(GAS unsigned long long*)(gp) = (unsigned long long)cvt_pk_bf16(s0[0], s0[1]) | ((unsigned long long)cvt_pk_bf16(s0[2], s0[3]) << 32);
                    *(GAS unsigned long long*)(gp + 1024) = (unsigned long long)cvt_pk_bf16(s1[0], s1[1]) | ((unsigned long long)cvt_pk_bf16(s1[2], s1[3]) << 32);
                    *(GAS unsigned long long*)(gp + 2048) = (unsigned long long)cvt_pk_bf16(s2[0], s2[1]) | ((unsigned long long)cvt_pk_bf16(s2[2], s2[3]) << 32);
                    *(GAS unsigned long long*)(gp + 3072) = (unsigned long long)cvt_pk_bf16(s3[0], s3[1]) | ((unsigned long long)cvt_pk_bf16(s3[2], s3[3]) << 32);
                    asm volatile("" ::: "memory");
                }
        } else {
            const bool is_vt = (pn == 9) || (pn == 6 && wc >= 2);
            if (!is_vt) {
                const float* gw = pn == 5 ? gq_swa : pn == 6 ? gk_swa : pn == 7 ? gq_fox : gk_fox;
                const float sc = (pn == 5 || pn == 7) ? P_QSCALE : 1.0f;
                bf16_t* dst = pn == 5 ? AQ : pn == 6 ? AK : pn == 7 ? FQ : FK; const int ld = pn == 6 ? 128 : 256;
                f32x4 gv[2][2];
#pragma unroll
                for (int bj = 0; bj < 2; ++bj)
#pragma unroll
                    for (int n = 0; n < 2; ++n) gv[bj][n] = *(const GAS f32x4*)(gw + 32 * bj + 8 * fq + 4 * n) * sc;
#pragma unroll
                for (int ai = 0; ai < 2; ++ai)
#pragma unroll
                    for (int m = 0; m < 4; ++m) {
                        const int row = row0 + ai * HALF + m * 16; const float rs = rsv[ai * 4 + m];
                        f32x4 v[2][2]; float q = 0.f;
#pragma unroll
                        for (int bj = 0; bj < 2; ++bj)
#pragma unroll
                            for (int n = 0; n < 2; ++n) { v[bj][n] = acc[ai][bj][m][n] * rs; const f32x4 t = v[bj][n]; q += (t[0] * t[0] + t[1] * t[1]) + (t[2] * t[2] + t[3] * t[3]); }
                        q += __shfl_xor(q, 16); q += __shfl_xor(q, 32);
                        const float r = rsqrtf(q * (1.0f / 64.0f) + P_EPS);
#pragma unroll
                        for (int bj = 0; bj < 2; ++bj) store8(dst + (size_t)row * ld + wc * 64 + 32 * bj + 8 * fq, v[bj][0] * r * gv[bj][0], v[bj][1] * r * gv[bj][1]);
                        asm volatile("" ::: "memory");
                    }
            } else {
                const int H = pn == 9 ? 4 : 2, head = pn == 9 ? wc : wc - 2; bf16_t* dst = pn == 9 ? FVt : AVt;
#pragma unroll
                for (int ai = 0; ai < 2; ++ai)
#pragma unroll
                    for (int m = 0; m < 4; ++m) {
                        const int row = row0 + ai * HALF + m * 16; const float rs = rsv[ai * 4 + m];
                        const int b = row / P_SEQ, t = row % P_SEQ;
#pragma unroll
                        for (int bj = 0; bj < 2; ++bj) {
                            const f32x4 a0 = acc[ai][bj][m][0] * rs, a1 = acc[ai][bj][m][1] * rs;
                            if (dst) { bf16_t* base = dst + ((size_t)(b * H + head) * 64 + 32 * bj + 8 * fq) * P_SEQ + t;
#pragma unroll
                                for (int i = 0; i < 4; ++i) { *(GAS bf16_t*)(base + (size_t)i * P_SEQ) = f2bf1(a0[i]); *(GAS bf16_t*)(base + (size_t)(4 + i) * P_SEQ) = f2bf1(a1[i]); } }
                            if (pn == 9 && FV) store8(FV + (size_t)row * 256 + wc * 64 + 32 * bj + 8 * fq, a0, a1);
                        }
                        asm volatile("" ::: "memory");
                    }
            }
        }
    }
};
template <int I> struct EpiMerge {
    static constexpr bool PERM = true, AFTER_DRAIN = false, KEEP = false, PREFETCH = false, RSDMA = false;
    unsigned char* ws;
    __device__ __forceinline__ void operator()(const f32x4 (&acc)[2][2][4][2], const Unit& u, int wr, int wc, int fr, int fq) const {
        const int row0 = u.pm * BM + wr * 64 + fr, col0 = u.pn * BM + wc * 32 + 8 * fq; const bf16_t* G = (const bf16_t*)(ws + WS_G); bf16_t* Mg = (bf16_t*)(ws + WS_R1);
#pragma unroll
        for (int ai = 0; ai < 2; ++ai)
#pragma unroll
            for (int m = 0; m < 4; ++m) {
                const int row = row0 + ai * HALF + m * 16;
#pragma unroll
                for (int bj = 0; bj < 2; ++bj) {
                    const int col = col0 + bj * HALF;
                    const u32x4 g = *(const u32x4*)(G + (size_t)row * 4096 + I * 1024 + col);
                    f32x4 v0 = acc[ai][bj][m][0] * bf_lo4(g.x, g.y), v1 = acc[ai][bj][m][1] * bf_lo4(g.z, g.w);
                    bf16_t* mp = Mg + (size_t)row * P_D + col;
                    if (I > 0) { const u32x4 o = *(const u32x4*)mp; v0 += bf_lo4(o.x, o.y); v1 += bf_lo4(o.z, o.w); }
                    store8(mp, v0, v1);
                }
                asm volatile("" ::: "memory");
            }
    }
};

struct MergeOrder {
    StaticOrder base;
    __device__ __forceinline__ bool next(int i, Unit& u) const { Unit b; if (!base.next(i >> 2, b)) return false; const int br = i & 3; u.pm = b.pm + 128 * br; u.pn = b.pn + 4 * br; return true; }
    __device__ __forceinline__ void a_ready(const Unit&) const {}
    __device__ __forceinline__ void done(const Unit&) const {}
};
struct EpiMergeH {
    static constexpr bool PERM = true, AFTER_DRAIN = false, KEEP = true, PREFETCH = false, RSDMA = false;
    unsigned char* ws;
    __device__ __forceinline__ bool keep(const Unit& u) const { return (u.pm >> 7) < 3; }
    __device__ __forceinline__ void operator()(const f32x4 (&acc_)[2][2][4][2], const Unit& u, int wr, int wc, int fr, int fq) const {
        f32x4 (&acc)[2][2][4][2] = const_cast<f32x4 (&)[2][2][4][2]>(acc_);
        const int br = u.pm >> 7, pm = u.pm & 127, pn = u.pn & 3;
        const int row0 = pm * BM + wr * 64 + fr, col0 = pn * BM + wc * 32 + 8 * fq; const bf16_t* S = (const bf16_t*)(ws + WS_G) + (size_t)br * 1024 + col0; bf16_t* Mg = (bf16_t*)(ws + WS_R1) + col0;
        u32x4 gv[2][4][2];
#pragma unroll
        for (int ai = 0; ai < 2; ++ai)
#pragma unroll
            for (int m = 0; m < 4; ++m)
#pragma unroll
                for (int bj = 0; bj < 2; ++bj) gv[ai][m][bj] = *(const GAS u32x4*)(S + (size_t)(row0 + ai * HALF + m * 16) * 4096 + bj * HALF);
#pragma unroll
        for (int ai = 0; ai < 2; ++ai)
#pragma unroll
            for (int m = 0; m < 4; ++m) {
                const int row = row0 + ai * HALF + m * 16;
#pragma unroll
                for (int bj = 0; bj < 2; ++bj) {
                    const f32x4 g0 = bf_lo4(gv[ai][m][bj].x, gv[ai][m][bj].y), g1 = bf_lo4(gv[ai][m][bj].z, gv[ai][m][bj].w);
                    if (br < 3) { acc[ai][bj][m][0] *= g0; acc[ai][bj][m][1] *= g1; }
                    else store8(Mg + (size_t)row * P_D + bj * HALF, acc[ai][bj][m][0] * g0, acc[ai][bj][m][1] * g1);
                }
            }
        asm volatile("" ::: "memory");
    }
};
template <class Epi, class Sched, bool ALIGN_EPI = false, bool SP2 = false>
__device__ __forceinline__ void gemm_phase(PG8_LAS unsigned char* lds, const Gemm g, const Sched& S, const Epi& E, const int tid_in) {
    int tid_ = tid_in; asm volatile("" : "+v"(tid_));
    const int tid = tid_, wid = __builtin_amdgcn_readfirstlane(tid >> 6), lane = tid & 63, wr = wid >> 2, wc = wid & 3, fr = lane & 15, fq = lane >> 4;
    const int K = g.K, nt = K / BK;
    unsigned voffA[2], voffB[2];
#pragma unroll
    for (int i = 0; i < 2; ++i) { int R, C; stage_rc(tid * 16 + i * 8192, R, C); const int Rb = Epi::PERM ? ((R & ~31) + perm32(R & 31)) : R;
        voffA[i] = (unsigned)(R * K + C) * 2u; voffB[i] = (unsigned)(Rb * K + C) * 2u; }
    const size_t kstep = (size_t)(BK * 2);
    const size_t hstep = (size_t)HALF * K * 2;
    const size_t tstep = 2 * hstep;
    const unsigned ldsw = (unsigned)wid * 1024u;
    const int aoff = lds_byte(wr * 64 + fr, fq * 8), boff = lds_byte(wc * 32 + fr, fq * 8);
#define PG8_SA(b, h) (((b) * 2 + (h)) * HTB)
#define PG8_SB(b, h) ((4 + (b) * 2 + (h)) * HTB)
#define PG8_STAGE(bufoff, gbase, voff) do { _Pragma("unroll") for (int _i = 0; _i < 2; ++_i) \
        __builtin_amdgcn_global_load_lds((const unsigned*)((const char*)(gbase) + (voff)[_i]), (PG8_LAS unsigned*)(lds + (bufoff) + ldsw + _i * 8192), 16, 0, 0); } while (0)
#define PG8_LDA(dst, b, h) do { _Pragma("unroll") for (int m = 0; m < 4; ++m) _Pragma("unroll") for (int k = 0; k < 2; ++k) dst[m][k] = *(const PG8_LAS bf16x8*)(lds + PG8_SA(b, h) + aoff + m * 2048 + k * 1024); } while (0)
#define PG8_LDB(dst, b, h) do { _Pragma("unroll") for (int n = 0; n < 2; ++n) _Pragma("unroll") for (int k = 0; k < 2; ++k) dst[n][k] = *(const PG8_LAS bf16x8*)(lds + PG8_SB(b, h) + boff + n * 2048 + k * 1024); } while (0)
#define PG8_MMA(ai, bj, At, Bt) do { __builtin_amdgcn_s_setprio(1); _Pragma("unroll") for (int m = 0; m < 4; ++m) _Pragma("unroll") for (int n = 0; n < 2; ++n) _Pragma("unroll") for (int k = 0; k < 2; ++k) \
        acc[ai][bj][m][n] = __builtin_amdgcn_mfma_f32_16x16x32_bf16(Bt[n][k], At[m][k], acc[ai][bj][m][n], 0, 0, 0); __builtin_amdgcn_s_setprio(0); } while (0)
#define PG8_WAIT_V(n) asm volatile("s_waitcnt vmcnt(" #n ")" ::: "memory")
#define PG8_WAIT_L(n) asm volatile("s_waitcnt lgkmcnt(" #n ")" ::: "memory")
#define PG8_BAR __builtin_amdgcn_s_barrier()
#define PG8_SCHED __builtin_amdgcn_sched_barrier(0)
    Unit cur, nxt; int ui = 0;
    if (!S.next(0, cur)) return;
    f32x4 acc[2][2][4][2];
#pragma unroll
    for (int a = 0; a < 2; ++a)
#pragma unroll
        for (int b = 0; b < 2; ++b)
#pragma unroll
            for (int m = 0; m < 4; ++m)
#pragma unroll
                for (int n = 0; n < 2; ++n) acc[a][b][m][n] = (f32x4){0.f, 0.f, 0.f, 0.f};
    bf16x8 At[4][2], B0[2][2], B1[2][2];
    const char* cA = (const char*)g.A + (size_t)cur.pm * tstep; const char* cB = (const char*)g.Bt + (size_t)cur.pn * tstep;
    S.a_ready(cur);
    if constexpr (SP2) {
        PG8_STAGE(PG8_SB(0, 0), cB, voffB); PG8_STAGE(PG8_SB(0, 1), cB + hstep, voffB); PG8_STAGE(PG8_SA(0, 0), cA, voffA); PG8_STAGE(PG8_SA(0, 1), cA + hstep, voffA);
        if (wr == 1) PG8_BAR;
        PG8_WAIT_V(2); PG8_BAR;
        PG8_STAGE(PG8_SB(1, 0), cB + kstep, voffB); PG8_STAGE(PG8_SA(1, 0), cA + kstep, voffA); PG8_STAGE(PG8_SB(1, 1), cB + hstep + kstep, voffB);
        PG8_WAIT_V(6); PG8_BAR;
    } else {
        PG8_STAGE(PG8_SB(0, 0), cB, voffB); PG8_STAGE(PG8_SA(0, 0), cA, voffA); PG8_STAGE(PG8_SB(0, 1), cB + hstep, voffB); PG8_STAGE(PG8_SA(0, 1), cA + hstep, voffA);
        if (wr == 1) PG8_BAR;
        PG8_WAIT_V(4); PG8_BAR;
        PG8_STAGE(PG8_SB(1, 0), cB + kstep, voffB); PG8_STAGE(PG8_SA(1, 0), cA + kstep, voffA); PG8_STAGE(PG8_SB(1, 1), cB + hstep + kstep, voffB);
        PG8_WAIT_V(6); PG8_BAR;
    }
#define PG8_RS_ISSUE(un) do { if constexpr (Epi::RSDMA) { if (wr == 1) { const char* gb_ = (const char*)(E.rs_src() + (size_t)(un).pm * BM * 16); \
        int l2_; asm volatile("v_mbcnt_lo_u32_b32 %0, -1, 0\n\tv_mbcnt_hi_u32_b32 %0, -1, %0" : "=v"(l2_)); \
        _Pragma("unroll") for (int j_ = 0; j_ < 4; ++j_) { const int p_ = wc * 4 + j_, g_ = p_ >> 3, r_ = (p_ & 7) * 16, tb_ = r_ < 64 ? g_ * 64 + r_ : HALF + g_ * 64 + (r_ - 64); \
            __builtin_amdgcn_global_load_lds((const unsigned*)(gb_ + (size_t)tb_ * 64 + (unsigned)l2_ * 16u), (PG8_LAS unsigned*)(lds + LDS_RS + g_ * 8192 + r_ * 64), 16, 0, 0); } } } } while (0)
    PG8_RS_ISSUE(cur);
    for (;;) {
        const bool has_next = S.next(ui + 1, nxt);
        const char* nA = has_next ? (const char*)g.A + (size_t)nxt.pm * tstep : cA; const char* nB = has_next ? (const char*)g.Bt + (size_t)nxt.pn * tstep : cB;
        for (int t = 0; t < nt; t += 2) {
            const bool last = (t == nt - 2);
            const char* a1 = cA + (size_t)(t + 1) * kstep;
            const char* a2 = last ? nA : cA + (size_t)(t + 2) * kstep; const char* b2 = last ? nB : cB + (size_t)(t + 2) * kstep;
            const char* a3 = a2 + kstep; const char* b3 = b2 + kstep;
            if (last && has_next) S.a_ready(nxt);
            if constexpr (Epi::PREFETCH) {
                if (t < 16) {
                    const char* pb = E.pf_base(cur) + (size_t)(wid * 32 + (t >> 1) * 4) * (P_D * 4) + lane * 16;
#pragma unroll
                    for (int q = 0; q < 4; ++q) __builtin_amdgcn_global_load_lds((const unsigned*)(pb + (size_t)q * (P_D * 4)), (PG8_LAS unsigned*)(lds + 131072 + 1024 + wid * 1024), 16, 0, 0);
                }
            }
            if constexpr (SP2) {
            PG8_LDB(B0, 0, 0); PG8_LDB(B1, 0, 1); PG8_SCHED; PG8_LDA(At, 0, 0); PG8_STAGE(PG8_SA(1, 1), a1 + hstep, voffA);
            PG8_WAIT_V(8); PG8_WAIT_L(0); PG8_BAR; PG8_MMA(0, 0, At, B0); PG8_MMA(0, 1, At, B1); PG8_BAR; PG8_SCHED;
            PG8_LDA(At, 0, 1); PG8_STAGE(PG8_SB(0, 0), b2, voffB); PG8_STAGE(PG8_SB(0, 1), b2 + hstep, voffB); PG8_STAGE(PG8_SA(0, 0), a2, voffA);
            PG8_WAIT_V(8); PG8_WAIT_L(0); PG8_BAR; PG8_MMA(1, 0, At, B0); PG8_MMA(1, 1, At, B1); PG8_BAR; PG8_SCHED;
            PG8_LDB(B0, 1, 0); PG8_LDB(B1, 1, 1); PG8_SCHED; PG8_LDA(At, 1, 0); PG8_STAGE(PG8_SA(0, 1), a2 + hstep, voffA);
            PG8_WAIT_V(8); PG8_WAIT_L(0); PG8_BAR; PG8_MMA(0, 0, At, B0); PG8_MMA(0, 1, At, B1); PG8_BAR; PG8_SCHED;
            PG8_LDA(At, 1, 1); PG8_STAGE(PG8_SB(1, 0), b3, voffB); PG8_STAGE(PG8_SB(1, 1), b3 + hstep, voffB); PG8_STAGE(PG8_SA(1, 0), a3, voffA);
            PG8_WAIT_V(8); PG8_WAIT_L(0); PG8_BAR; PG8_MMA(1, 0, At, B0); PG8_MMA(1, 1, At, B1); PG8_BAR; PG8_SCHED;
            } else {
            PG8_LDB(B0, 0, 0); PG8_SCHED; PG8_LDA(At, 0, 0); PG8_STAGE(PG8_SA(1, 1), a1 + hstep, voffA);
            PG8_WAIT_L(8); PG8_BAR; PG8_WAIT_L(0); PG8_MMA(0, 0, At, B0); PG8_BAR; PG8_SCHED;
            PG8_LDB(B1, 0, 1); PG8_STAGE(PG8_SB(0, 0), b2, voffB);
            PG8_BAR; PG8_WAIT_L(0); PG8_MMA(0, 1, At, B1); PG8_BAR;
            PG8_LDA(At, 0, 1); PG8_STAGE(PG8_SA(0, 0), a2, voffA);
            PG8_BAR; PG8_WAIT_L(0); PG8_MMA(1, 0, At, B0); PG8_BAR; PG8_SCHED;
            PG8_STAGE(PG8_SB(0, 1), b2 + hstep, voffB);
            PG8_WAIT_V(6); PG8_BAR; PG8_MMA(1, 1, At, B1); PG8_BAR;
            PG8_LDB(B0, 1, 0); PG8_SCHED; PG8_LDA(At, 1, 0); PG8_STAGE(PG8_SA(0, 1), a2 + hstep, voffA);
            PG8_WAIT_L(8); PG8_BAR; PG8_WAIT_L(0); PG8_MMA(0, 0, At, B0); PG8_BAR; PG8_SCHED;
            PG8_LDB(B1, 1, 1); PG8_STAGE(PG8_SB(1, 0), b3, voffB);
            PG8_BAR; PG8_WAIT_L(0); PG8_MMA(0, 1, At, B1); PG8_BAR;
            PG8_LDA(At, 1, 1); PG8_STAGE(PG8_SA(1, 0), a3, voffA);
            PG8_BAR; PG8_WAIT_L(0); PG8_MMA(1, 0, At, B0); PG8_BAR; PG8_SCHED;
            PG8_STAGE(PG8_SB(1, 1), b3 + hstep, voffB);
            PG8_WAIT_V(6); PG8_BAR; PG8_MMA(1, 1, At, B1); PG8_BAR;
            }
        }
        if constexpr (ALIGN_EPI) { if (wr == 0) PG8_BAR; }
        if constexpr (!Epi::AFTER_DRAIN) { int ln_; asm volatile("v_mbcnt_lo_u32_b32 %0, -1, 0\n\tv_mbcnt_hi_u32_b32 %0, -1, %0" : "=v"(ln_));
            E(acc, cur, wr, wc, ln_ & 15, ln_ >> 4); S.done(cur); }
        if (!has_next) break;
        bool keep_ = false; if constexpr (Epi::KEEP) keep_ = E.keep(cur);
        if (!keep_) {
#pragma unroll
        for (int a = 0; a < 2; ++a)
#pragma unroll
            for (int b = 0; b < 2; ++b)
#pragma unroll
                for (int m = 0; m < 4; ++m)
#pragma unroll
                    for (int n = 0; n < 2; ++n) acc[a][b][m][n] = (f32x4){0.f, 0.f, 0.f, 0.f};
        }
        cur = nxt; cA = nA; cB = nB; ++ui;
        if constexpr (ALIGN_EPI) { if (wr == 1) PG8_BAR; }
        PG8_RS_ISSUE(cur);
    }
    PG8_WAIT_V(0);
    if constexpr (!ALIGN_EPI) { if (wr == 0) PG8_BAR; }
    PG8_BAR;
    if constexpr (Epi::AFTER_DRAIN) { E.fused(acc, cur, wr, wc, fr, fq, lds, wid, lane); S.done(cur); }
#undef PG8_SA
#undef PG8_SB
#undef PG8_STAGE
#undef PG8_LDA
#undef PG8_LDB
#undef PG8_MMA
#undef PG8_WAIT_V
#undef PG8_WAIT_L
#undef PG8_BAR
#undef PG8_SCHED
#undef PG8_RS_ISSUE
}
}
#include <hip/hip_bf16.h>
#include <cmath>
namespace attn_body {
using bf16=__hip_bfloat16;
using bf16x8=__attribute__((ext_vector_type(8)))short;
using s16x4=__attribute__((ext_vector_type(4)))short;
using f32x16=__attribute__((ext_vector_type(16)))float;
using u32x4=__attribute__((ext_vector_type(4)))unsigned;
constexpr int BATCH=4,NHEAD=4,SEQ=8192,D=64,DM=NHEAD*D;
constexpr int NW=8,QBLK=32,QB=QBLK*NW,KVBLK=64,NQB=SEQ/QB;
constexpr int ATTN_PITCH=DM, ATTN_UNIT_ROWS=QB;
__device__ __forceinline__ int crow(int r,int hi){return (r&3)+8*(r>>2)+4*hi;}
#define SBAR() __builtin_amdgcn_sched_barrier(0)
__device__ __forceinline__ void cmask(f32x16&p0,f32x16&p1,int jb,int qrel,int hi){
  const float NEG=-INFINITY; int kb=64*jb+4*hi;
  #pragma unroll
  for(int r=0;r<16;++r){int kv=kb+(r&3)+8*(r>>2); if(kv>qrel)p0[r]=NEG; if(kv+32>qrel)p1[r]=NEG;}
}

constexpr int NSLOT=3, SLOTB=8192;
constexpr int LDS_K=0, LDS_V=NSLOT*SLOTB, LDS_WS=2*NSLOT*SLOTB, LDS_OST=LDS_WS+NW*64*4, LDS_F=LDS_OST+NW*4096, LDS_BYTES=LDS_F+SEQ*4;
constexpr float C2=0.125f*1.4426950408889634f;
__device__ __forceinline__ void glds16(const void*gsrc,unsigned lds_dst){unsigned keep;
  asm volatile("s_mov_b32 %0, m0\n\ts_mov_b32 m0, %2\n\ts_nop 0\n\tglobal_load_lds_dwordx4 %1, off\n\ts_mov_b32 m0, %0":"=&s"(keep):"v"(gsrc),"s"(lds_dst):"memory");}
__device__ __forceinline__ float max3f(float a,float b,float c){float r;asm("v_max3_f32 %0, %1, %2, %3":"=v"(r):"v"(a),"v"(b),"v"(c));return r;}
__device__ __forceinline__ float max2f(float a,float b){float r;asm("v_max_f32_e32 %0, %1, %2":"=v"(r):"v"(a),"v"(b));return r;}
__device__ __forceinline__ float fadd_s(float a,float b){float r;asm("v_add_f32_e32 %0, %1, %2":"=v"(r):"v"(a),"v"(b));return r;}
__device__ __forceinline__ float fsub_s(float a,float b){float r;asm("v_sub_f32_e32 %0, %1, %2":"=v"(r):"v"(a),"v"(b));return r;}
typedef float f32x2_t __attribute__((ext_vector_type(2))); typedef __bf16 bf16x2_t __attribute__((ext_vector_type(2)));
__device__ __forceinline__ unsigned cvtpk_s(float lo,float hi){f32x2_t v={lo,hi};bf16x2_t b=__builtin_convertvector(v,bf16x2_t);return __builtin_bit_cast(unsigned,b);}
#define WAIT_BAR(N) asm volatile("s_waitcnt vmcnt(" #N ") lgkmcnt(0)\n\ts_barrier":::"memory")

__device__ __forceinline__ void qkt(f32x16&p0,f32x16&p1,const char*Kslot,const bf16x8*qr,const f32x16&negm,int r32,int hi){
  const char*kb=Kslot+hi*1024+r32*16;
  #pragma unroll
  for(int d0=0;d0<4;++d0){
    const bf16x8 b0=*reinterpret_cast<const bf16x8*>(kb+d0*2048);
    const bf16x8 b1=*reinterpret_cast<const bf16x8*>(kb+d0*2048+512);
    if(d0==0){p0=__builtin_amdgcn_mfma_f32_32x32x16_bf16(b0,qr[0],negm,0,0,0);p1=__builtin_amdgcn_mfma_f32_32x32x16_bf16(b1,qr[0],negm,0,0,0);}
    else{p0=__builtin_amdgcn_mfma_f32_32x32x16_bf16(b0,qr[d0],p0,0,0,0);p1=__builtin_amdgcn_mfma_f32_32x32x16_bf16(b1,qr[d0],p1,0,0,0);}}
}
typedef __attribute__((address_space(3))) const char* lds_cptr;
typedef short v4i16_t __attribute__((ext_vector_type(4)));
typedef float f32x4v __attribute__((ext_vector_type(4)));
__device__ __forceinline__ void kload8(bf16x8*kf,lds_cptr kp){
  kf[0]=*(const __attribute__((address_space(3))) bf16x8*)(kp);      kf[1]=*(const __attribute__((address_space(3))) bf16x8*)(kp+512);
  kf[2]=*(const __attribute__((address_space(3))) bf16x8*)(kp+2048); kf[3]=*(const __attribute__((address_space(3))) bf16x8*)(kp+2560);
  kf[4]=*(const __attribute__((address_space(3))) bf16x8*)(kp+4096); kf[5]=*(const __attribute__((address_space(3))) bf16x8*)(kp+4608);
  kf[6]=*(const __attribute__((address_space(3))) bf16x8*)(kp+6144); kf[7]=*(const __attribute__((address_space(3))) bf16x8*)(kp+6656);
}
__device__ __forceinline__ void kload2(bf16x8*kf,lds_cptr kp,int j){ kf[2*j]=*(const __attribute__((address_space(3))) bf16x8*)(kp+j*2048); kf[2*j+1]=*(const __attribute__((address_space(3))) bf16x8*)(kp+j*2048+512); }
__device__ __forceinline__ s16x4 vtr(lds_cptr p){ return __builtin_bit_cast(s16x4,__builtin_amdgcn_ds_read_tr16_b64_v4i16((__attribute__((address_space(3))) v4i16_t*)p)); }
__device__ __forceinline__ float rowmax(const f32x16&p0,const f32x16&p1){
  float a=max3f(p0[0],p0[1],p1[0]),b=max3f(p0[2],p0[3],p1[1]);a=max3f(a,p1[2],p1[3]);
  #pragma unroll
  for(int r=4;r<16;r+=4){a=max3f(a,p0[r],p0[r+1]);b=max3f(b,p0[r+2],p0[r+3]);a=max3f(a,p1[r],p1[r+1]);b=max3f(b,p1[r+2],p1[r+3]);}
  const float m=max2f(a,b);
  auto rr=__builtin_amdgcn_permlane32_swap(__float_as_uint(m),__float_as_uint(m),false,false);
  return max2f(__uint_as_float(rr[0]),__uint_as_float(rr[1]));
}
__device__ __forceinline__ void pv(f32x16*o,int vb,bf16x8 pa0,bf16x8 pa1,bf16x8 pa2,bf16x8 pa3){
  #pragma unroll
  for(int d0=0;d0<2;++d0){s16x4 lo[4],hi[4];
    #pragma unroll
    for(int ks=0;ks<4;++ks){
      asm volatile("ds_read_b64_tr_b16 %0,%1 offset:%c2":"=&v"(lo[ks]):"v"(vb),"i"(d0*4096+ks*1024):"memory");
      asm volatile("ds_read_b64_tr_b16 %0,%1 offset:%c2":"=&v"(hi[ks]):"v"(vb),"i"(d0*4096+ks*1024+512):"memory");}
    asm volatile("s_waitcnt lgkmcnt(0)":::"memory");SBAR();
    #define PK(k) (bf16x8){lo[k][0],lo[k][1],lo[k][2],lo[k][3],hi[k][0],hi[k][1],hi[k][2],hi[k][3]}
    o[d0]=__builtin_amdgcn_mfma_f32_32x32x16_bf16(pa0,PK(0),o[d0],0,0,0);
    o[d0]=__builtin_amdgcn_mfma_f32_32x32x16_bf16(pa1,PK(1),o[d0],0,0,0);
    o[d0]=__builtin_amdgcn_mfma_f32_32x32x16_bf16(pa2,PK(2),o[d0],0,0,0);
    o[d0]=__builtin_amdgcn_mfma_f32_32x32x16_bf16(pa3,PK(3),o[d0],0,0,0);
    #undef PK
  }
}

#ifndef ATTN_STORE16
#define ATTN_STORE16(p,v) (*(GAS u32x4*)(p)=(v))
#endif
template<int THRL> __device__ __forceinline__ void attn_unit(int b,int h,int qb,const bf16*Q,const bf16*__restrict__ K,const bf16*__restrict__ V,bf16*O,const float*__restrict__ Fc,float skipTH,char*shm,int tid_in){
  int tid=tid_in; asm volatile("":"+v"(tid));
  const int lane=tid&63,r32=lane&31,hi=lane>>5; const int wid=__builtin_amdgcn_readfirstlane(tid>>6);
  const long rowbase=(long)b*SEQ; const int q0=qb*QB;
  const bf16*Qw=Q+(rowbase+q0+wid*QBLK)*DM+h*D;
  const int NTF=(q0+QB)/KVBLK; int t0;
  { const GAS float*fb=(const GAS float*)(Fc+(long)(b*NHEAD+h)*SEQ); const float fq=fb[q0]; const int j0=lane,j1=lane+64;
    const bool c0=(j0<NTF-4)&&(fq-fb[64*j0+63]<-skipTH), c1=(j1<NTF-4)&&(fq-fb[(64*j1+63)&(SEQ-1)]<-skipTH);
    const unsigned long long m0=~__ballot(c0), m1=~__ballot(c1);
    const int js=m0?__builtin_ctzll(m0):64+(m1?__builtin_ctzll(m1):64);
    t0=__builtin_amdgcn_readfirstlane(js)&~1; }
  const bf16*Kh=K+(rowbase+(long)t0*KVBLK)*DM+h*D,*Vh=V+(rowbase+(long)t0*KVBLK)*DM+h*D;
  const unsigned lds0=(unsigned)(uintptr_t)shm;
  float*wsf=(float*)(shm+LDS_WS)+wid*64;
  const bf16*ksrc=Kh+(long)lane*DM+wid*8;
  const bf16*vsrc=Vh+(long)(16*(wid&3)+(lane>>2))*DM+(wid>>2)*32+(lane&3)*8;
  const unsigned kdst=lds0+LDS_K+wid*1024, vdst=lds0+LDS_V+wid*1024;
  #define DMA_K(t,slot) glds16(ksrc+(long)(t)*KVBLK*DM,(unsigned)__builtin_amdgcn_readfirstlane(kdst+(slot)))
  #define DMA_V(t,slot) glds16(vsrc+(long)(t)*KVBLK*DM,(unsigned)__builtin_amdgcn_readfirstlane(vdst+(slot)))
  const int vb0=(int)(lds0+LDS_V)+((lane>>4)&1)*32+(lane&3)*8+(4*hi+((lane&15)>>2))*64;
  const char*Kbase=shm+LDS_K; bf16x8 kf[8];
  const int NT=NTF-t0;
  const lds_cptr shm3=(lds_cptr)shm; const lds_cptr kp0=shm3+LDS_K+hi*1024+r32*16; const lds_cptr vp0=shm3+LDS_V+((lane>>4)&1)*32+(lane&3)*8+(4*hi+((lane&15)>>2))*64;
  const lds_cptr fl0=shm3+LDS_F+hi*16;
  #define FLDS(p) (*(const __attribute__((address_space(3))) f32x4v*)(p))
  #define FBIAS(P0,P1,t) do{ const lds_cptr fp_=fl0+(t)*256; f32x4v a_[4],b_[4]; \
    _Pragma("unroll") for(int g_=0;g_<4;++g_){ a_[g_]=FLDS(fp_+g_*32); b_[g_]=FLDS(fp_+128+g_*32); } \
    _Pragma("unroll") for(int g_=0;g_<4;++g_) _Pragma("unroll") for(int i_=0;i_<4;++i_){ P0[4*g_+i_]-=(a_[g_][i_]+mhat); P1[4*g_+i_]-=(b_[g_][i_]+mhat); } }while(0)
  f32x4v fba[4],fbb[4];
  #define FBLD_A(t) do{ const lds_cptr fp_=fl0+(t)*256; _Pragma("unroll") for(int g_=0;g_<4;++g_)fba[g_]=FLDS(fp_+g_*32); }while(0)
  #define FBLD_B(t) do{ const lds_cptr fp_=fl0+(t)*256+128; _Pragma("unroll") for(int g_=0;g_<4;++g_)fbb[g_]=FLDS(fp_+g_*32); }while(0)
  #define FBAPPLY(P0,P1) do{ _Pragma("unroll") for(int g_=0;g_<4;++g_) _Pragma("unroll") for(int i_=0;i_<4;++i_)P0[4*g_+i_]-=(fba[g_][i_]+mhat); \
    _Pragma("unroll") for(int g_=0;g_<4;++g_) _Pragma("unroll") for(int i_=0;i_<4;++i_)P1[4*g_+i_]-=(fbb[g_][i_]+mhat); }while(0)
  DMA_K(0,0);DMA_V(0,0);DMA_K(1,SLOTB);
  bf16x8 qr[4];
  #pragma unroll
  for(int d0=0;d0<4;++d0)qr[d0]=*(const GAS bf16x8*)(&Qw[(long)r32*DM+d0*16+hi*8]);
  {
    const GAS f32x4v*fsrc=(const GAS f32x4v*)(Fc+(long)(b*NHEAD+h)*SEQ+(long)t0*KVBLK); f32x4v*fdst=reinterpret_cast<f32x4v*>(shm+LDS_F);
    for(int i=tid;i<NT*KVBLK/4;i+=NW*64)fdst[i]=fsrc[i];
    asm volatile("s_waitcnt vmcnt(0) lgkmcnt(0)\n\ts_barrier":::"memory"); }
  float mhat=0.f,l_reg=0.f;f32x16 o[2];o[0]=f32x16{};o[1]=f32x16{};const f32x16 negm=f32x16{};
  const int qrel=wid*QBLK+r32;
  #define CMASK(P0,P1,t) do{int jb_=(t)-(NT-4); if(jb_>=0)cmask(P0,P1,jb_,qrel,hi);}while(0)
  bool resc=false;
  #define START(P0,P1) do{ const float rm=rowmax(P0,P1); resc=false; \
    { const float dl=rm; mhat=fadd_s(mhat,dl); \
      _Pragma("unroll") for(int r=0;r<16;++r){P0[r]=fsub_s(P0[r],dl);P1[r]=fsub_s(P1[r],dl);} \
      } \
    _Pragma("unroll") for(int r=0;r<16;++r)P0[r]=__builtin_amdgcn_exp2f(P0[r]); }while(0)
  #define RESC() do{ if(resc){ asm volatile("s_waitcnt lgkmcnt(0)":::"memory"); \
      _Pragma("unroll") for(int d_=0;d_<2;++d_) _Pragma("unroll") for(int r=0;r<16;++r)o[d_][r]*=wsf[crow(r,hi)]; } }while(0)
  f32x16 pA0,pA1,pB0,pB1;
  int sl_prev=0,sl_cur=0,sl_next=SLOTB;
  #define ROT() do{sl_prev=sl_cur;sl_cur=sl_next;sl_next=(sl_next==(NSLOT-1)*SLOTB)?0:sl_next+SLOTB;}while(0)
  DMA_K(2,2*SLOTB);
  WAIT_BAR(3);
  qkt(pA0,pA1,Kbase,qr,negm,r32,hi);asm volatile("s_nop 15\n\ts_nop 7":"+v"(pA0),"+v"(pA1));FBIAS(pA0,pA1,0);CMASK(pA0,pA1,0);
  START(pA0,pA1);
  _Pragma("unroll") for(int r=0;r<16;++r)pA1[r]=__builtin_amdgcn_exp2f(pA1[r]);
  WAIT_BAR(0);
  DMA_K(3,0);DMA_V(1,SLOTB);
  ROT();
  kload8(kf,kp0+sl_cur);
  WAIT_BAR(2);
  s16x4 vlo[8],vhi[8]; u32x4 pw0,pw1,pw2,pw3;
  #define PKW(P,B) cvtpk_s(P[B],P[B+1])
  #define PAF(k) __builtin_bit_cast(bf16x8,pw##k)
  #define VFR(i) (bf16x8){vlo[i][0],vlo[i][1],vlo[i][2],vlo[i][3],vhi[i][0],vhi[i][1],vhi[i][2],vhi[i][3]}
  #define PIN(x) asm volatile("":"+v"(x))
  #define MX3(a,b,c) __builtin_fmaxf(__builtin_fmaxf((a),(b)),(c))
  #define GAPA(MF,A0,A1,A2,A3,W0,W1,PW) do{ MF; sacc+=A0; sacc+=A1; sacc+=A2; sacc+=A3; PIN(sacc); W0; W1; PIN(PW); SBAR(); }while(0)
  #define EX(v) __builtin_amdgcn_exp2f(v)
  #define GAPB(MF,X,B) do{ MF; X[B]=EX(X[B]); X[B+1]=EX(X[B+1]); X[B+2]=EX(X[B+2]); X[B+3]=EX(X[B+3]); PIN(X); SBAR(); }while(0)
  #define VRD(i) do{ vlo[i]=vtr(vp_+(((i)>>2)*4096+((i)&3)*1024)); vhi[i]=vtr(vp_+(((i)>>2)*4096+((i)&3)*1024+512)); }while(0)
  #define KRD(G,j) do{ if(G){ kload2(kf,kp0+sl_next,j); SBAR(); } }while(0)
  #define STEP(C0,C1,P0,P1,t,GK,GV,GL) do{ SBAR(); \
    const lds_cptr vp_=vp0+sl_prev; \
    VRD(0); SBAR(); float sacc=(P0[0]+P0[1]); \
    GAPA(C0=__builtin_amdgcn_mfma_f32_32x32x16_bf16(kf[0],qr[0],negm,0,0,0), P0[2],P0[3],P0[4],P0[5],     pw0[0]=PKW(P0,0), pw0[1]=PKW(P0,2), pw0); \
    VRD(4); SBAR(); GAPA(C1=__builtin_amdgcn_mfma_f32_32x32x16_bf16(kf[1],qr[0],negm,0,0,0), P0[6],P0[7],P0[8],P0[9],     pw0[2]=PKW(P0,4), pw0[3]=PKW(P0,6), pw0); \
    VRD(1); SBAR(); GAPA(C0=__builtin_amdgcn_mfma_f32_32x32x16_bf16(kf[2],qr[1],C0,0,0,0),   P0[10],P0[11],P0[12],P0[13], pw1[0]=PKW(P0,8), pw1[1]=PKW(P0,10), pw1); \
    VRD(5); SBAR(); GAPA(C1=__builtin_amdgcn_mfma_f32_32x32x16_bf16(kf[3],qr[1],C1,0,0,0),   P0[14],P0[15],P1[0],P1[1],   pw1[2]=PKW(P0,12),pw1[3]=PKW(P0,14), pw1); \
    VRD(2); SBAR(); GAPA(C0=__builtin_amdgcn_mfma_f32_32x32x16_bf16(kf[4],qr[2],C0,0,0,0),   P1[2],P1[3],P1[4],P1[5],     pw2[0]=PKW(P1,0), pw2[1]=PKW(P1,2), pw2); \
    VRD(6); SBAR(); GAPA(C1=__builtin_amdgcn_mfma_f32_32x32x16_bf16(kf[5],qr[2],C1,0,0,0),   P1[6],P1[7],P1[8],P1[9],     pw2[2]=PKW(P1,4), pw2[3]=PKW(P1,6), pw2); \
    FBLD_A(t); VRD(3); SBAR(); GAPA(C0=__builtin_amdgcn_mfma_f32_32x32x16_bf16(kf[6],qr[3],C0,0,0,0),   P1[10],P1[11],P1[12],P1[13], pw3[0]=PKW(P1,8), pw3[1]=PKW(P1,10), pw3); \
    VRD(7); SBAR(); GAPA(C1=__builtin_amdgcn_mfma_f32_32x32x16_bf16(kf[7],qr[3],C1,0,0,0),   P1[14],P1[15],0.f,0.f,       pw3[2]=PKW(P1,12),pw3[3]=PKW(P1,14), pw3); \
    FBLD_B(t); l_reg+=sacc; \
    if(GK){DMA_K((t)+3,sl_cur);} if(GV){DMA_V((t)+1,sl_next);} \
    FBAPPLY(C0,C1); CMASK(C0,C1,t); \
    { float a=MX3(C0[0],C0[1],C1[0]),b=MX3(C0[2],C0[3],C1[1]); a=MX3(a,C1[2],C1[3]); \
      _Pragma("unroll") for(int r=4;r<16;r+=4){a=MX3(a,C0[r],C0[r+1]);b=MX3(b,C0[r+2],C0[r+3]);a=MX3(a,C1[r],C1[r+1]);b=MX3(b,C1[r+2],C1[r+3]);} \
      float rm=__builtin_fmaxf(a,b); { auto rr=__builtin_amdgcn_permlane32_swap(__float_as_uint(rm),__float_as_uint(rm),false,false); rm=__builtin_fmaxf(__uint_as_float(rr[0]),__uint_as_float(rr[1])); } \
      resc=false; \
      if(__builtin_expect(__any(rm>(float)THRL),0)){ const float dl=__builtin_fmaxf(rm,0.f); mhat+=dl; \
        _Pragma("unroll") for(int r=0;r<16;++r){C0[r]-=dl;C1[r]-=dl;} \
        const float f=__builtin_amdgcn_exp2f(-dl); l_reg*=f; if(hi==0)wsf[r32]=f; resc=true; } } \
    SBAR(); \
    GAPB(o[0]=__builtin_amdgcn_mfma_f32_32x32x16_bf16(PAF(0),VFR(0),o[0],0,0,0), C0,0); \
    GAPB(o[1]=__builtin_amdgcn_mfma_f32_32x32x16_bf16(PAF(0),VFR(4),o[1],0,0,0), C0,4); \
    KRD(GL,0); GAPB(o[0]=__builtin_amdgcn_mfma_f32_32x32x16_bf16(PAF(1),VFR(1),o[0],0,0,0), C0,8); \
    KRD(GL,1); GAPB(o[1]=__builtin_amdgcn_mfma_f32_32x32x16_bf16(PAF(1),VFR(5),o[1],0,0,0), C0,12); \
    KRD(GL,2); GAPB(o[0]=__builtin_amdgcn_mfma_f32_32x32x16_bf16(PAF(2),VFR(2),o[0],0,0,0), C1,0); \
    KRD(GL,3); GAPB(o[1]=__builtin_amdgcn_mfma_f32_32x32x16_bf16(PAF(2),VFR(6),o[1],0,0,0), C1,4); \
    GAPB(o[0]=__builtin_amdgcn_mfma_f32_32x32x16_bf16(PAF(3),VFR(3),o[0],0,0,0), C1,8); \
    GAPB(o[1]=__builtin_amdgcn_mfma_f32_32x32x16_bf16(PAF(3),VFR(7),o[1],0,0,0), C1,12); \
    }while(0)
  int t=1;
  #undef CMASK
  #define CMASK(P0,P1,t) do{}while(0)
  for(;t+5<NT;t+=2){
    STEP(pB0,pB1,pA0,pA1,t,true,true,true);     WAIT_BAR(2); RESC(); ROT();
    STEP(pA0,pA1,pB0,pB1,t+1,true,true,true);   WAIT_BAR(2); RESC(); ROT();
  }
  #undef CMASK
  #define CMASK(P0,P1,t) do{int jb_=(t)-(NT-4); if(jb_>=0)cmask(P0,P1,jb_,qrel,hi);}while(0)
  #define ENDW(tt) do{ if((tt)+3<NT){WAIT_BAR(2);} else if((tt)+2<NT){WAIT_BAR(1);} else {WAIT_BAR(0);} }while(0)
  for(;t+1<NT;t+=2){
    STEP(pB0,pB1,pA0,pA1,t,(t+3<NT),(t+1<NT),(t+1<NT));       ENDW(t);   RESC(); ROT();
    STEP(pA0,pA1,pB0,pB1,t+1,(t+4<NT),(t+2<NT),(t+2<NT));     ENDW(t+1); RESC(); ROT();
  }
  STEP(pB0,pB1,pA0,pA1,NT-1,false,false,false); RESC();
  { float sacc=pB0[0]+pB0[1]; _Pragma("unroll") for(int r=2;r<16;++r)sacc+=pB0[r]; _Pragma("unroll") for(int r=0;r<16;++r)sacc+=pB1[r]; l_reg+=sacc;
    pw0=(u32x4){PKW(pB0,0),PKW(pB0,2),PKW(pB0,4),PKW(pB0,6)};pw1=(u32x4){PKW(pB0,8),PKW(pB0,10),PKW(pB0,12),PKW(pB0,14)};pw2=(u32x4){PKW(pB1,0),PKW(pB1,2),PKW(pB1,4),PKW(pB1,6)};pw3=(u32x4){PKW(pB1,8),PKW(pB1,10),PKW(pB1,12),PKW(pB1,14)};
    SBAR(); pv(o,vb0+sl_cur,PAF(0),PAF(1),PAF(2),PAF(3)); }
  #undef PKW
  #undef PAF
  #undef VFR
  #undef PIN
  #undef MX3
  #undef GAPA
  #undef GAPB
  #undef EX
  #undef VRD
  #undef KRD
  #undef STEP
  #undef ENDW
  {auto rr=__builtin_amdgcn_permlane32_swap(__float_as_uint(l_reg),__float_as_uint(l_reg),false,false);l_reg=__uint_as_float(rr[0])+__uint_as_float(rr[1]);}
  if(hi==0)wsf[32+r32]=l_reg;asm volatile("s_waitcnt lgkmcnt(0)":::"memory");
  float rli[16];
  #pragma unroll
  for(int r=0;r<16;++r)rli[r]=__builtin_amdgcn_rcpf(wsf[32+crow(r,hi)]);
  bf16*Ow=O+(rowbase+q0+wid*QBLK)*DM+h*D;
  { bf16*stg=(bf16*)(shm+LDS_OST)+wid*2048;
    #pragma unroll
    for(int r=0;r<16;++r){const int orow=crow(r,hi);
      #pragma unroll
      for(int d0=0;d0<2;++d0)stg[orow*64+d0*32+r32]=__float2bfloat16(o[d0][r]*rli[r]);}
    asm volatile("s_waitcnt lgkmcnt(0)":::"memory");
    #pragma unroll
    for(int i=0;i<4;++i){const int row=i*8+(lane>>3),ch=lane&7; const u32x4 v=*(const u32x4*)(stg+row*64+ch*8); ATTN_STORE16(Ow+(long)row*DM+ch*8,v);} }
  asm volatile("s_waitcnt lgkmcnt(0)\n\ts_barrier":::"memory");
  #undef DMA_K
  #undef DMA_V
  #undef CMASK
  #undef START
  #undef RESC
  #undef ROT
  #undef FBIAS
  #undef FLDS
  #undef FBLD_A
  #undef FBLD_B
  #undef FBAPPLY
}
constexpr int ATTN_LDS_BYTES=LDS_BYTES;
struct AttnTensors { const bf16* Q; const bf16* K; const bf16* V; bf16* O; const float* Fc; float skipTH; };
struct AttnUnit { int bh; int qb; };
struct StaticOrder {
  int vcu,nv;
  __device__ __forceinline__ explicit StaticOrder(int grid,int block):vcu((grid%8==0)?(block%8)*(grid/8)+block/8:block),nv(grid){}
  __device__ __forceinline__ bool next(int i,AttnUnit&u)const{ const int pairu=vcu+(i>>1)*nv; if(pairu>=256)return false; const int s=pairu&15; u.bh=pairu>>4; u.qb=(i&1)?31-s:s; return true; }
  __device__ __forceinline__ void a_ready(const AttnUnit&)const{}
  __device__ __forceinline__ void done(const AttnUnit&)const{}
};
template<class Sched,int THRL=48> __device__ __forceinline__ void attn_phase(char*lds,const AttnTensors&T,const Sched&S,int tid){
  AttnUnit u;
  for(int i=0;S.next(i,u);++i){ S.a_ready(u); attn_unit<THRL>(u.bh/NHEAD,u.bh%NHEAD,u.qb,T.Q,T.K,T.V,T.O,T.Fc,T.skipTH,lds,tid); S.done(u); }
}
#undef SBAR
#undef WAIT_BAR
}
namespace cg = cooperative_groups;
using pg8::bf16_t; using pg8::f32x4; using pg8::u32x4; using pg8::bf16x8;
typedef float f32x16 __attribute__((ext_vector_type(16)));
typedef short s16x4 __attribute__((ext_vector_type(4)));
#define LAS __attribute__((address_space(3)))

struct Params { const float* in[28]; float* out; unsigned char* ws; };
typedef const __attribute__((address_space(4))) Params* PP;

__device__ __forceinline__ float wave_sum(float v) {
#pragma unroll
    for (int o = 1; o < 64; o <<= 1) v += __shfl_xor(v, o);
    return v;
}
__device__ __forceinline__ unsigned f2bf(float f) { unsigned u = __float_as_uint(f); return (u + 0x7fffu + ((u >> 16) & 1u)) >> 16; }
__device__ __forceinline__ unsigned pk2(float lo, float hi) { return f2bf(lo) | (f2bf(hi) << 16); }
__device__ __forceinline__ float bflo(unsigned u) { return __uint_as_float(u << 16); }
__device__ __forceinline__ float bfhi(unsigned u) { return __uint_as_float(u & 0xffff0000u); }

__device__ __forceinline__ void wconv_item(const float* W, int ldw, int scl  , const float* g, bf16_t* WT, int K, int dr0, int k0, float* scr, int lane) {
    float wv[32];
#pragma unroll
    for (int i = 0; i < 32; ++i) { const int kk = 2 * i + (lane >> 5); wv[i] = W[(size_t)(k0 + kk) * ldw + scl]; }
    if (g) {
#pragma unroll
        for (int i = 0; i < 32; ++i) wv[i] *= g[k0 + 2 * i + (lane >> 5)];
    }
#pragma unroll
    for (int i = 0; i < 32; ++i) scr[(2 * i + (lane >> 5)) * 33 + (lane & 31)] = wv[i];
    asm volatile("s_waitcnt lgkmcnt(0)" ::: "memory");
    const int c = lane & 7;
#pragma unroll
    for (int j = 0; j < 4; ++j) { const int n = (lane >> 3) + 8 * j; const float* s = scr + (8 * c) * 33 + n;
        u32x4 o; o.x = pk2(s[0 * 33], s[1 * 33]); o.y = pk2(s[2 * 33], s[3 * 33]); o.z = pk2(s[4 * 33], s[5 * 33]); o.w = pk2(s[6 * 33], s[7 * 33]);
        *(u32x4*)(WT + (size_t)(dr0 + n) * K + k0 + 8 * c) = o; }
    asm volatile("s_waitcnt lgkmcnt(0)" ::: "memory");
}
__device__ __forceinline__ int win_src_col(int db, int j) {
    const int pn = db >> 3, bj = (db >> 2) & 1, w = db & 3;
    if (pn < 2) return (bj ? 256 : 0) + 128 * pn + 32 * w + j;
    if (pn < 4) return (bj ? 1024 : 768) + 128 * (pn - 2) + 32 * w + j;
    if (pn == 4) return 512 + 128 * bj + 32 * w + j;
    if (pn == 5) return 1280 + 64 * w + 32 * bj + j;
    if (pn == 6) return (w < 2 ? 1536 + 64 * w : 1664 + 64 * (w - 2)) + 32 * bj + j;
    if (pn == 7) return 1792 + 64 * w + 32 * bj + j;
    if (pn == 8) return 2048 + 64 * w + 32 * bj + j;
    if (pn == 9) return 2304 + 64 * w + 32 * bj + j;
    const int fq = j >> 3, n = (j >> 2) & 1, i = j & 3;
    return 2564 + (2 * bj + n) * 1024 + 64 * (pn - 10) + 16 * w + 4 * fq + i;
}
__device__ __forceinline__ void wprep_layer(PP pp, int l, unsigned char* lds, int gw, int ngw, int wave, int lane) {
    float* scr = (float*)(lds + wave * 16384);
    bf16_t* wb = (bf16_t*)(GAS bf16_t*)(pp->ws + WS_W);
    constexpr int I0 = 176 * 16, I1 = 32 * 44, I2 = 208 * 16, I3 = 128 * 4, I4 = 32 * 16;
    constexpr int NIT = I0 + I1 + I2 + I3 + I4 + I0 + I1;
    for (int it = gw; it < NIT; it += ngw) {
        int r = it;
        if (r < I0 || (r >= I0 + I1 + I2 + I3 + I4 && r < I0 + I1 + I2 + I3 + I4 + I0)) {
            const bool second = r >= I0; if (second) r -= I0 + I1 + I2 + I3 + I4;
            const int db = r % 176, kb = r / 176, pn = db >> 3, bj = (db >> 2) & 1, w = db & 3;
            const float* src = ((const float*)(GAS const float*)pp->in[second ? (bj ? 26 : 25) : (bj ? 4 : 3)]) + (size_t)l * D * DFF;
            const float* g = ((const float*)(GAS const float*)pp->in[second ? 24 : 2]) + l * D;
            wconv_item(src, DFF, 128 * pn + 32 * w + (lane & 31), g, (bf16_t*)((unsigned char*)wb + (second ? W_2GU : W_1GU)), D, db * 32, kb * 64, scr, lane);
            continue;
        }
        r -= I0;
        if (r < I1 || r >= I1 + I2 + I3 + I4 + I0) {
            const bool second = r >= I1; if (second) r -= I1 + I2 + I3 + I4 + I0;
            const int db = r % 32, kb = r / 32;
            wconv_item(((const float*)(GAS const float*)pp->in[second ? 27 : 5]) + (size_t)l * DFF * D, D, 32 * db + (lane & 31), nullptr, (bf16_t*)((unsigned char*)wb + (second ? W_2D : W_1D)), DFF, db * 32, kb * 64, scr, lane);
            continue;
        }
        r -= I1;
        if (r < I2) { const int db = r % 208, kb = r / 208;
            wconv_item(((const float*)(GAS const float*)pp->in[7]) + (size_t)l * D * INC, INC, win_src_col(db, lane & 31), ((const float*)(GAS const float*)pp->in[6]) + l * D, (bf16_t*)((unsigned char*)wb + W_IN), D, db * 32, kb * 64, scr, lane); continue; }
        r -= I2;
        if (r < I3) { const int db = r % 128, kb = r / 128, i = db >> 5;
            const float* src = ((const float*)(GAS const float*)pp->in[i == 0 ? 13 : i == 1 ? 15 : i == 2 ? 19 : 22]) + (size_t)l * 256 * D;
            wconv_item(src, D, 32 * (db & 31) + (lane & 31), nullptr, (bf16_t*)((unsigned char*)wb + W_BR), 256, db * 32, kb * 64, scr, lane); continue; }
        r -= I3;
        { const int db = r % 32, kb = r / 32;
            wconv_item(((const float*)(GAS const float*)pp->in[23]) + (size_t)l * D * D, D, 32 * db + (lane & 31), nullptr, (bf16_t*)((unsigned char*)wb + W_OUT), D, db * 32, kb * 64, scr, lane); }
    }
}
__device__ __forceinline__ void prep_x(const float* x, bf16_t* xb, float* ss, int gw, int ngw, int lane) {
    for (int m0 = gw; m0 < M; m0 += 4 * ngw) {
        f32x4 v[4][4];
#pragma unroll
        for (int r = 0; r < 4; ++r) { const int m = m0 + r * ngw < M ? m0 + r * ngw : M - 1; const GAS f32x4* xr = (const GAS f32x4*)(x + (size_t)m * D) + lane;
#pragma unroll
            for (int j = 0; j < 4; ++j) v[r][j] = xr[64 * j]; }
#pragma unroll
        for (int r = 0; r < 4; ++r) {
            const int m = m0 + r * ngw; if (m >= M) break;
            float s = 0.f;
#pragma unroll
            for (int j = 0; j < 4; ++j) s += (v[r][j][0] * v[r][j][0] + v[r][j][1] * v[r][j][1]) + (v[r][j][2] * v[r][j][2] + v[r][j][3] * v[r][j][3]);
            s = wave_sum(s);
            GAS unsigned long long* o8 = (GAS unsigned long long*)(xb + (size_t)m * D) + lane;
#pragma unroll
            for (int j = 0; j < 4; ++j) o8[64 * j] = (unsigned long long)pk2(v[r][j][0], v[r][j][1]) | ((unsigned long long)pk2(v[r][j][2], v[r][j][3]) << 32);
            if (lane < 16) *(GAS float*)(ss + (size_t)m * 16 + lane) = lane == 0 ? s : 0.f;
        }
    }
}
__device__ __forceinline__ void forget_rows(PP pp, int l, const bf16_t* x, const float* ss, float* lf, unsigned char* lds, int gw, int ngw, int tid, int lane) {
    float* wf = (float*)lds;
    const float* win = ((const float*)(GAS const float*)pp->in[7]) + (size_t)l * D * INC + 2560; const float* g = ((const float*)(GAS const float*)pp->in[6]) + l * D;
    for (int k = tid; k < D; k += NTHR) { const float gk = g[k]; const float* w = win + (size_t)k * INC;
#pragma unroll
        for (int h = 0; h < 4; ++h) wf[h * D + k] = w[h] * gk; }
    __syncthreads();
    const float* bf = ((const float*)(GAS const float*)pp->in[8]) + l * 4;
    for (int m0 = gw; m0 < M; m0 += 4 * ngw) {
        u32x4 xv[4][2]; float rsr[4];
#pragma unroll
        for (int r = 0; r < 4; ++r) { const int m = m0 + r * ngw < M ? m0 + r * ngw : M - 1; const GAS u32x4* xr = (const GAS u32x4*)(x + (size_t)m * D) + lane; xv[r][0] = xr[0]; xv[r][1] = xr[64]; rsr[r] = pg8::rs_row(ss, m); }
#pragma unroll
        for (int r = 0; r < 4; ++r) {
            const int m = m0 + r * ngw; f32x4 a = (f32x4){0.f, 0.f, 0.f, 0.f};
#pragma unroll
            for (int j = 0; j < 2; ++j) { const int k0 = 512 * j + 8 * lane; const f32x4 v0 = pg8::bf_lo4(xv[r][j].x, xv[r][j].y), v1 = pg8::bf_lo4(xv[r][j].z, xv[r][j].w);
#pragma unroll
                for (int h = 0; h < 4; ++h) { const f32x4 w0 = *(const f32x4*)(wf + h * D + k0), w1 = *(const f32x4*)(wf + h * D + k0 + 4);
                    a[h] += ((w0[0] * v0[0] + w0[1] * v0[1]) + (w0[2] * v0[2] + w0[3] * v0[3])) + ((w1[0] * v1[0] + w1[1] * v1[1]) + (w1[2] * v1[2] + w1[3] * v1[3])); } }
#pragma unroll
            for (int h = 0; h < 4; ++h) { const float f = wave_sum(a[h]) * rsr[r] + bf[h]; const float v = fminf(f, 0.f) - __logf(1.0f + __expf(-fabsf(f))); if (lane == h && m < M) *(GAS float*)(lf + (size_t)m * 4 + h) = v; }
        }
    }
    __syncthreads();
}
__device__ __forceinline__ void forget_scan(const float* lf, float* fc, unsigned char* lds, int seq, int wave, int lane) {
    const int b = seq >> 2, h = seq & 3; float* wtot = (float*)lds;
    const int t0 = 1024 * wave + 16 * lane; float v[16]; float s = 0.f;
#pragma unroll
    for (int i = 0; i < 16; ++i) { v[i] = *(const GAS float*)(lf + ((size_t)b * SEQ + t0 + i) * 4 + h); s += v[i]; }
    float inc = s;
#pragma unroll
    for (int o = 1; o < 64; o <<= 1) { const float t = __shfl_up(inc, o); if (lane >= o) inc += t; }
    if (lane == 63) wtot[wave] = inc;
    __syncthreads();
    float run = inc - s;
    for (int w = 0; w < wave; ++w) run += wtot[w];
#pragma unroll
    for (int i = 0; i < 16; ++i) { run += v[i]; *(GAS float*)(fc + (size_t)seq * SEQ + t0 + i) = run * LOG2E; }
    __syncthreads();
}
__device__ __forceinline__ void conformer_unit(int unit, const bf16_t* U, const float* dw, const float* dwb, const float* lng, const float* lnb, bf16_t* out, unsigned char* lds, int tid, int wave, int lane) {
    const int r0 = unit * 64, tl0 = r0 % SEQ;
    unsigned short* ub = (unsigned short*)lds;
    float* yb = (float*)(lds + 49152);
    { u32x4 v[6];
#pragma unroll
        for (int i = 0; i < 6; ++i) { const int c = tid + i * NTHR, rr = c >> 5, ch = c & 31; v[i] = (u32x4){0u, 0u, 0u, 0u};
            if (c < 94 * 32 && tl0 - 30 + rr >= 0) v[i] = *(const GAS u32x4*)(U + (size_t)(r0 - 30 + rr) * 256 + ch * 8); }
#pragma unroll
        for (int i = 0; i < 6; ++i) { const int c = tid + i * NTHR, rr = c >> 5, ch = c & 31; if (c < 94 * 32) *(u32x4*)(ub + rr * 256 + ch * 8) = v[i]; } }
    __syncthreads();
    {
        typedef float f32x2c __attribute__((ext_vector_type(2)));
        const int cp = tid & 127, tg = tid >> 7; f32x2c w2[31], a2[16];
#pragma unroll
        for (int k = 0; k < 31; ++k) w2[k] = *(const GAS f32x2c*)(dw + k * 256 + 2 * cp);
        const f32x2c b2 = *(const GAS f32x2c*)(dwb + 2 * cp);
#pragma unroll
        for (int j = 0; j < 16; ++j) a2[j] = b2;
#pragma unroll
        for (int r = 0; r < 46; ++r) {
            const unsigned pv = *(const unsigned*)(ub + (tg * 16 + r) * 256 + 2 * cp); const f32x2c u2 = (f32x2c){bflo(pv), bfhi(pv)};
#pragma unroll
            for (int j = (r > 30 ? r - 30 : 0); j <= (r < 15 ? r : 15); ++j) a2[j] += w2[r - j] * u2;
        }
#pragma unroll
        for (int j = 0; j < 16; ++j) *(f32x2c*)(yb + (tg * 16 + j) * 256 + 2 * cp) = a2[j]; }
    __syncthreads();
    { const f32x4 g = *(const GAS f32x4*)(lng + 4 * lane), bb = *(const GAS f32x4*)(lnb + 4 * lane);
#pragma unroll 1
        for (int j = wave; j < 64; j += NWAVES) {
            const f32x4 v = *(const f32x4*)(yb + j * 256 + 4 * lane);
            const float mean = wave_sum((v[0] + v[1]) + (v[2] + v[3])) * (1.0f / 256.0f);
            const f32x4 d = v - mean;
            const float var = wave_sum((d[0] * d[0] + d[1] * d[1]) + (d[2] * d[2] + d[3] * d[3])) * (1.0f / 256.0f);
            const float rstd = rsqrtf(var + EPS);
            f32x4 o = d * rstd * g + bb;
#pragma unroll
            for (int i = 0; i < 4; ++i) o[i] = pg8::fsilu(o[i]);
            *(GAS unsigned long long*)(out + (size_t)(r0 + j) * 256 + 4 * lane) = (unsigned long long)pk2(o[0], o[1]) | ((unsigned long long)pk2(o[2], o[3]) << 32);
        } }
    __syncthreads();
}
__device__ __forceinline__ void shortconv_all(const bf16_t* __restrict__ SCX, const bf16_t* __restrict__ SB, const float* __restrict__ w, bf16_t* __restrict__ out, int gtid, int ngt) {
    for (int it = gtid; it < (M / 8) * 32; it += ngt) {
        const int ch = it & 31, r0 = (it >> 5) * 8; const bool head = (r0 % SEQ) == 0;
        u32x4 xs[10], sb[8];
#pragma unroll
        for (int r = 0; r < 10; ++r) { const int rr = (r < 2 && head) ? r0 : r0 - 2 + r; xs[r] = *(const GAS u32x4*)(SCX + (size_t)rr * 256 + 8 * ch); }
#pragma unroll
        for (int r = 0; r < 8; ++r) sb[r] = *(const GAS u32x4*)(SB + (size_t)(r0 + r) * 256 + 8 * ch);
        if (head) { xs[0] = (u32x4){0u, 0u, 0u, 0u}; xs[1] = (u32x4){0u, 0u, 0u, 0u}; }
        f32x4 wv[3][2];
#pragma unroll
        for (int k = 0; k < 3; ++k)
#pragma unroll
            for (int hh = 0; hh < 2; ++hh) wv[k][hh] = *(const GAS f32x4*)(w + k * 256 + 8 * ch + 4 * hh);
#pragma unroll
        for (int r = 0; r < 8; ++r) {
            f32x4 o[2];
#pragma unroll
            for (int hh = 0; hh < 2; ++hh) {
                const f32x4 a0 = hh ? pg8::bf_lo4(xs[r].z, xs[r].w) : pg8::bf_lo4(xs[r].x, xs[r].y), a1 = hh ? pg8::bf_lo4(xs[r + 1].z, xs[r + 1].w) : pg8::bf_lo4(xs[r + 1].x, xs[r + 1].y),
                            a2 = hh ? pg8::bf_lo4(xs[r + 2].z, xs[r + 2].w) : pg8::bf_lo4(xs[r + 2].x, xs[r + 2].y);
                const f32x4 sv = hh ? pg8::bf_lo4(sb[r].z, sb[r].w) : pg8::bf_lo4(sb[r].x, sb[r].y);
                o[hh] = sv * (wv[0][hh] * a0 + wv[1][hh] * a1 + wv[2][hh] * a2);
            }
            pg8::store8(out + (size_t)(r0 + r) * 256 + 8 * ch, o[0], o[1]);
        }
    }
}
__device__ __forceinline__ int crow(int r, int hi) { return (r & 3) + 8 * (r >> 2) + 4 * hi; }
#define MFMA32(a, b, c) __builtin_amdgcn_mfma_f32_32x32x16_bf16((a), (b), (c), 0, 0, 0)
template <int MODE>
__device__ __forceinline__ void attn_wave_unit(const bf16_t* Q, int qpitch, const bf16_t* K, int kpitch, const bf16_t* Vt, bf16_t* O, int q0,
                                               const float* Fk, const float* btab, float sink2, float* wsf, int lane) {
    const int r32 = lane & 31, hi = lane >> 5;
    bf16x8 qf[4];
#pragma unroll
    for (int d0 = 0; d0 < 4; ++d0) qf[d0] = *(const GAS bf16x8*)(Q + (size_t)(q0 + r32) * qpitch + 16 * d0 + 8 * hi);
    f32x16 o0, o1;
#pragma unroll
    for (int r = 0; r < 16; ++r) { o0[r] = 0.f; o1[r] = 0.f; }
    float m_run = MODE == 0 ? sink2 : -1e30f, l_run = (MODE == 0 && hi == 0) ? 1.f : 0.f;
    const int ks_begin = MODE == 0 ? (q0 >= 128 ? q0 - 128 : 0) : 0, ks_end = q0;
    const int qq = q0 + r32;
    bf16x8 kf[4];
#pragma unroll
    for (int d0 = 0; d0 < 4; ++d0) kf[d0] = *(const GAS bf16x8*)(K + (size_t)(ks_begin + r32) * kpitch + 16 * d0 + 8 * hi);
    for (int ks = ks_begin; ks <= ks_end; ks += 32) {
        s16x4 vlo[2][2], vhh[2][2]; bf16x8 kn[4];
#pragma unroll
        for (int st = 0; st < 2; ++st)
#pragma unroll
            for (int db = 0; db < 2; ++db) { const bf16_t* vp = Vt + (size_t)(r32 + 32 * db) * SEQ + ks + 16 * st + 4 * hi; vlo[st][db] = *(const GAS s16x4*)vp; vhh[st][db] = *(const GAS s16x4*)(vp + 8); }
        { const int kq = ks + 32 <= ks_end ? ks + 32 : ks;
#pragma unroll
            for (int d0 = 0; d0 < 4; ++d0) kn[d0] = *(const GAS bf16x8*)(K + (size_t)(kq + r32) * kpitch + 16 * d0 + 8 * hi); }
        f32x16 s;
#pragma unroll
        for (int r = 0; r < 16; ++r) s[r] = 0.f;
#pragma unroll
        for (int d0 = 0; d0 < 4; ++d0) { s = MFMA32(kf[d0], qf[d0], s); kf[d0] = kn[d0]; }
        float bmax = -1e30f;
#pragma unroll
        for (int g = 0; g < 4; ++g) {
            f32x4 fk4 = (f32x4){0.f, 0.f, 0.f, 0.f};
            if (MODE == 1) fk4 = *(const GAS f32x4*)(Fk + ks + 8 * g + 4 * hi);
#pragma unroll
            for (int i = 0; i < 4; ++i) { const int r = 4 * g + i, key = ks + 8 * g + 4 * hi + i; float v;
                if (MODE == 1) v = key <= qq ? s[r] - fk4[i] : -1e30f;
                else { v = s[r] + btab[qq - key + 32]; }
                s[r] = v; bmax = fmaxf(bmax, v); }
        }
        bmax = fmaxf(bmax, __shfl_xor(bmax, 32));
        const float m_new = fmaxf(m_run, bmax), alpha = __builtin_amdgcn_exp2f(m_run - m_new); m_run = m_new;
        float lsum = 0.f;
#pragma unroll
        for (int r = 0; r < 16; ++r) { s[r] = __builtin_amdgcn_exp2f(s[r] - m_new); lsum += s[r]; }
        l_run = l_run * alpha + lsum;
        if (hi == 0) wsf[r32] = alpha;
        asm volatile("s_waitcnt lgkmcnt(0)" ::: "memory");
#pragma unroll
        for (int g = 0; g < 4; ++g) { const f32x4 a4 = *(const f32x4*)(wsf + 8 * g + 4 * hi);
#pragma unroll
            for (int i = 0; i < 4; ++i) { o0[4 * g + i] *= a4[i]; o1[4 * g + i] *= a4[i]; } }
        asm volatile("s_waitcnt lgkmcnt(0)" ::: "memory");
#pragma unroll
        for (int st = 0; st < 2; ++st) {
            u32x4 pw; pw.x = pg8::cvt_pk_bf16(s[8 * st + 0], s[8 * st + 1]); pw.y = pg8::cvt_pk_bf16(s[8 * st + 2], s[8 * st + 3]); pw.z = pg8::cvt_pk_bf16(s[8 * st + 4], s[8 * st + 5]); pw.w = pg8::cvt_pk_bf16(s[8 * st + 6], s[8 * st + 7]);
            const bf16x8 pa = __builtin_bit_cast(bf16x8, pw);
#pragma unroll
            for (int db = 0; db < 2; ++db) {
                const bf16x8 vb = __builtin_shufflevector(vlo[st][db], vhh[st][db], 0, 1, 2, 3, 4, 5, 6, 7);
                if (db == 0) o0 = MFMA32(pa, vb, o0); else o1 = MFMA32(pa, vb, o1);
            }
        }
    }
    l_run += __shfl_xor(l_run, 32);
    if (hi == 0) wsf[r32] = 1.0f / l_run;
    asm volatile("s_waitcnt lgkmcnt(0)" ::: "memory");
#pragma unroll
    for (int g = 0; g < 4; ++g) { const f32x4 a4 = *(const f32x4*)(wsf + 8 * g + 4 * hi);
#pragma unroll
        for (int i = 0; i < 4; ++i) { const int r = 4 * g + i; bf16_t* op = O + (size_t)(q0 + crow(r, hi)) * 256 + r32;
            *(GAS bf16_t*)op = (bf16_t)f2bf(o0[r] * a4[i]); *(GAS bf16_t*)(op + 32) = (bf16_t)f2bf(o1[r] * a4[i]); } }
    asm volatile("s_waitcnt lgkmcnt(0)" ::: "memory");
}

#define XB_TMO      128
#define XB_XCNT(j)  (256  + 64 * (j))
#define XB_XSUB(j)  (1280 + 64 * (j))
#define XB_XGEN(j)  (2304 + 64 * (j))
#define XB_TOP      3328
#define XB_TOPGEN   3392
#define XCD_BAR_WORDS 3456
#define XB_SPIN_CAP (1u << 18)

__device__ __forceinline__ unsigned xb_ld(unsigned* p)              { return __hip_atomic_load(p, __ATOMIC_RELAXED, __HIP_MEMORY_SCOPE_AGENT); }
__device__ __forceinline__ unsigned xb_add(unsigned* p, unsigned v) { return __hip_atomic_fetch_add(p, v, __ATOMIC_RELAXED, __HIP_MEMORY_SCOPE_AGENT); }
__device__ __forceinline__ unsigned xb_xcc_id() { return (unsigned)__builtin_amdgcn_s_getreg((3 << 11) | 20) & 0xFu; }
#define XB_SPIN(cond, bar) do { unsigned _sp = 0; while (cond) { __builtin_amdgcn_s_sleep(1); \
    if ((++_sp & 255u) == 0u) { if (xb_ld(&(bar)[XB_TMO])) break; if (_sp > XB_SPIN_CAP) { atomicAdd(&(bar)[XB_TMO], 1u); break; } } } } while (0)

struct XcdBarrier {
    unsigned* bar; unsigned x; bool lead;
    volatile LAS unsigned* st;
};

__device__ __forceinline__ XcdBarrier xcd_barrier_post(unsigned* bar, volatile LAS unsigned* st) {
    XcdBarrier b; b.bar = bar; b.x = xb_xcc_id(); b.st = st;
    if (threadIdx.x == 0) (void)xb_add(&bar[XB_XCNT(b.x)], 1u);
    return b;
}
__device__ __forceinline__ void xcd_barrier_complete(unsigned* bar, unsigned x, unsigned& nloc, unsigned& nx) {
    const unsigned G = gridDim.x * gridDim.y * gridDim.z;
    unsigned sum, cnt, mine, sp = 0u;
    for (;;) {
        sum = 0u; cnt = 0u; mine = 0u;
#pragma unroll
        for (unsigned j = 0; j < 16; ++j) { const unsigned c = xb_ld(&bar[XB_XCNT(j)]); sum += c; cnt += (c > 0u) ? 1u : 0u; mine = (j == x) ? c : mine; }
        if (sum == G) break;
        __builtin_amdgcn_s_sleep(1);
        if ((++sp & 255u) == 0u) { if (xb_ld(&bar[XB_TMO])) break; if (sp > XB_SPIN_CAP) { atomicAdd(&bar[XB_TMO], 1u); break; } }
    }
    nloc = mine > 0u ? mine : 1u; nx = cnt > 0u ? cnt : 1u;
}

__device__ __forceinline__ void xcd_barrier(const XcdBarrier& b) {
    asm volatile("s_waitcnt vmcnt(0)" ::: "memory");
    __syncthreads();
    if (b.lead) {
        unsigned* bar = b.bar;
        __builtin_amdgcn_s_waitcnt(0);
        unsigned nloc = b.st[0], nx = b.st[1];
        if (nloc == 0u) { xcd_barrier_complete(bar, b.x, nloc, nx); b.st[0] = nloc; b.st[1] = nx; }
        const unsigned old = xb_add(&bar[XB_XSUB(b.x)], 1u);
        const unsigned gen = old / nloc;
        if (old + 1u == (gen + 1u) * nloc) {
            __builtin_amdgcn_fence(__ATOMIC_RELEASE, "agent");
            asm volatile("s_waitcnt vmcnt(0)" ::: "memory");
            const unsigned og = xb_add(&bar[XB_TOP], 1u);
            const unsigned tg = og / nx;
            if (og + 1u == (tg + 1u) * nx) xb_add(&bar[XB_TOPGEN], 1u);
            else XB_SPIN(xb_ld(&bar[XB_TOPGEN]) == tg, bar);
            __builtin_amdgcn_fence(__ATOMIC_ACQUIRE, "agent");
            xb_add(&bar[XB_XGEN(b.x)], 1u);
            asm volatile("s_waitcnt vmcnt(0)" ::: "memory");
        } else {
            XB_SPIN(xb_ld(&bar[XB_XGEN(b.x)]) == gen, bar);
            __builtin_amdgcn_fence(__ATOMIC_ACQUIRE, "agent");
            asm volatile("s_waitcnt vmcnt(0)" ::: "memory");
        }
    }
    __syncthreads();
}

#define GIN(k) ((const float*)(GAS const float*)pp->in[k])
#define GOUT ((float*)(GAS float*)pp->out)
#define PH_BEGIN() PP pp = (PP)__builtin_amdgcn_kernarg_segment_ptr(); asm volatile("" : "+s"(pp)); unsigned char* w = pp->ws; asm volatile("" : "+s"(w)); \
    int lane; asm volatile("v_mbcnt_lo_u32_b32 %0, -1, 0\n\tv_mbcnt_hi_u32_b32 %0, -1, %0" : "=v"(lane)); int wave = wave0; asm volatile("" : "+s"(wave)); const int tid = wave * 64 + lane; \
    int bid = blockIdx.x; asm volatile("" : "+s"(bid)); \
    const int G = gridDim.x, gw = bid * NWAVES + wave, ngw = G * NWAVES; (void)tid; (void)gw; (void)ngw; \
    PG8_LAS unsigned char* lds3 = (PG8_LAS unsigned char*)lds; (void)lds3
__global__ void __launch_bounds__(NTHR, 2) fwd_kernel(Params p) {
    extern __shared__ __attribute__((aligned(16))) unsigned char lds[];
    const int wave0 = __builtin_amdgcn_readfirstlane((int)threadIdx.x >> 6);
    volatile LAS unsigned* MISC = (volatile LAS unsigned*)((LAS unsigned char*)lds + 131072 + 320);
    if (threadIdx.x < 32) MISC[threadIdx.x] = 0u;
    __syncthreads();
    cg::this_grid().sync();
    { PP pp0 = (PP)__builtin_amdgcn_kernarg_segment_ptr(); XcdBarrier xbar = xcd_barrier_post((unsigned*)(pp0->ws + WS_CTL) + 4096, MISC + 8); if (threadIdx.x == 0) MISC[10] = xbar.x; }
    __syncthreads();
#define GRID_SYNC() do { PP pq_ = (PP)__builtin_amdgcn_kernarg_segment_ptr(); asm volatile("" : "+s"(pq_)); int ln_; asm volatile("v_mbcnt_lo_u32_b32 %0, -1, 0\n\tv_mbcnt_hi_u32_b32 %0, -1, %0" : "=v"(ln_)); \
        int wv_ = wave0; asm volatile("" : "+s"(wv_)); volatile LAS unsigned* st_ = (volatile LAS unsigned*)((LAS unsigned char*)lds + 131072 + 320) + 8; \
        XcdBarrier xb_; xb_.bar = (unsigned*)(pq_->ws + WS_CTL) + 4096; xb_.lead = (wv_ == 0 && ln_ == 0); xb_.x = xb_.lead ? st_[2] : 0u; xb_.st = st_; xcd_barrier(xb_); } while (0)
#ifdef DIAG_FILL
    {
        PH_BEGIN();
        u32x4 pz = (u32x4){0xAAAAAAAAu, 0xAAAAAAAAu, 0xAAAAAAAAu, 0xAAAAAAAAu};
        u32x4* a = (u32x4*)(w + 2 * MiB); const size_t n = (WS_END - 2 * MiB) / 16;
        for (size_t i = (size_t)bid * NTHR + tid; i < n; i += (size_t)G * NTHR) a[i] = pz;
        u32x4* o = (u32x4*)GOUT; const size_t no = (size_t)M * D * 4 / 16;
        for (size_t i = (size_t)bid * NTHR + tid; i < no; i += (size_t)G * NTHR) o[i] = pz;
    }
    GRID_SYNC();
#endif
#ifndef SKIP_PREP
#ifdef DUP_PREP
#pragma unroll 1
    for (int rep_ = 0; rep_ < 2; ++rep_) {
#endif
    {
        PH_BEGIN();
        prep_x(GIN(0), (bf16_t*)(w + WS_XB), (float*)(w + WS_SSP), gw, ngw, lane);
        if (bid == 0) { float* cw = (float*)(w + WS_CONST); const int l = tid >> 8, r = tid & 255, which = r >> 6, i = r & 63;
            cw[tid] = GIN(which == 0 ? 16 : which == 1 ? 17 : which == 2 ? 20 : 21)[l * 64 + i]; }
        wprep_layer(pp, 0, lds, gw, ngw, wave, lane);
    }
#ifdef DUP_PREP
    GRID_SYNC(); }
#endif
#endif
    GRID_SYNC();
#ifdef DUP_BAR
#pragma unroll 1
    for (int rep_ = 0; rep_ < 20; ++rep_) { GRID_SYNC(); }
#endif
#pragma unroll 1
    for (int l = 0; l < 2; ++l) {
        if (l > 0) { { PH_BEGIN(); wprep_layer(pp, l, lds, gw, ngw, wave, lane); } GRID_SYNC(); }
#pragma unroll 1
        for (int j = 0; j < 3; ++j) {
            if (j != 1) {
#ifndef SKIP_FFNUP
#ifdef DUP_FFNUP
#pragma unroll 1
                for (int rep_ = 0; rep_ < 2; ++rep_) {
#endif
                PH_BEGIN();
                pg8::Gemm g{(const bf16_t*)(w + WS_XB), (const bf16_t*)(w + WS_W + (j == 0 ? W_1GU : W_2GU)), M, 2 * DFF, D};
                pg8::StaticOrder S; S.init(M, 2 * DFF, G, bid);
                pg8::EpiSwiglu E{w, (const float*)(w + WS_SSP), (PG8_LAS const float*)(lds3 + LDS_RS)};
                pg8::gemm_phase<pg8::EpiSwiglu, pg8::StaticOrder, true, true>(lds3, g, S, E, tid);
#ifdef DUP_FFNUP
                }
#endif
#endif
            } else {
#ifndef SKIP_FROWS
#ifdef DUP_FROWS
#pragma unroll 1
                for (int rep_ = 0; rep_ < 2; ++rep_) {
#endif
                { PH_BEGIN(); forget_rows(pp, l, (const bf16_t*)(w + WS_XB), (const float*)(w + WS_SSP), (float*)(w + WS_LF), lds, gw, ngw, tid, lane); }
#ifdef DUP_FROWS
                }
#endif
#endif
#ifndef SKIP_WIN
#ifdef DUP_WIN
#pragma unroll 1
                for (int rep_ = 0; rep_ < 2; ++rep_) {
#endif
                {
                    PH_BEGIN();
                    pg8::Gemm g{(const bf16_t*)(w + WS_XB), (const bf16_t*)(w + WS_W + W_IN), M, NWIN, D};
                    pg8::StaticOrder S; S.init(M, NWIN, G, bid);
                    pg8::EpiWin E{w, (const float*)(w + WS_SSP), l, (PG8_LAS const float*)(lds3 + LDS_RS)};
                    pg8::gemm_phase<pg8::EpiWin, pg8::StaticOrder, true, true>(lds3, g, S, E, tid);
                }
#ifdef DUP_WIN
                }
#endif
#endif
                GRID_SYNC();
#ifndef SKIP_SCAN
                { PH_BEGIN(); for (int seq = bid; seq < 16; seq += G) forget_scan((const float*)(w + WS_LF), (float*)(w + WS_FC), lds, seq, wave, lane); }
#endif
#if !DYNQ
#ifndef SKIP_CONF
#ifdef DUP_CONF
#pragma unroll 1
                for (int rep_ = 0; rep_ < 2; ++rep_) {
#endif
                { PH_BEGIN(); for (int u = bid; u < M / 64; u += G)
                    conformer_unit(u, (const bf16_t*)(w + WS_R1 + R_U), GIN(9) + l * 31 * 256, GIN(10) + l * 256, GIN(11) + l * 256, GIN(12) + l * 256, (bf16_t*)GOUT  , lds, tid, wave, lane); }
#ifdef DUP_CONF
                }
#endif
#endif
#ifndef SKIP_SC
#ifdef DUP_SC
#pragma unroll 1
                for (int rep_ = 0; rep_ < 2; ++rep_) {
#endif
                { PH_BEGIN(); shortconv_all((const bf16_t*)(w + WS_R1 + R_SCX), (const bf16_t*)(w + WS_R1 + R_SB), GIN(14) + l * 3 * 256, (bf16_t*)GOUT + (size_t)M * 256  , bid * NTHR + tid, G * NTHR); }
#ifdef DUP_SC
                }
#endif
#endif
#ifndef SKIP_SWA
#ifdef DUP_SWA
#pragma unroll 1
                for (int rep_ = 0; rep_ < 2; ++rep_) {
#endif
                {
                    PH_BEGIN();
                    float* btab = (float*)lds;
                    float* wsf = (float*)(lds + 4096) + wave * 64;
                    for (int e = tid; e < 4 * 192; e += NTHR) { const int h = e / 192, dist = e % 192 - 32; float v = -1e30f;
                        if (dist >= 0 && dist < 128) { int bucket = dist;
                            if (dist >= 16) { bucket = 16 + (int)(logf((float)dist / 16.0f) / 2.0794415416798357f * 16.0f); bucket = bucket > 31 ? 31 : bucket; }
                            v = GIN(1)[bucket * 4 + h] * LOG2E; }
                        btab[e] = v; }
                    __syncthreads();
                    const bf16_t* r1 = (const bf16_t*)(w + WS_R1);
#pragma unroll 1
                    for (int u = gw; u < BATCH * 4 * (SEQ / 32); u += ngw) {
                        const int qblk = u & 255, hq = (u >> 8) & 3, b = u >> 10, kvh = hq >> 1;
                        attn_wave_unit<0>(r1 + R_AQ / 2 + (size_t)b * SEQ * 256 + hq * 64, 256, r1 + R_AK / 2 + (size_t)b * SEQ * 128 + kvh * 64, 128,
                                          r1 + R_AVT / 2 + (size_t)(b * 2 + kvh) * 64 * SEQ, (bf16_t*)GOUT + (size_t)2 * M * 256 + (size_t)b * SEQ * 256 + hq * 64, qblk * 32,
                                          nullptr, btab + hq * 192, GIN(18)[l * 4 + hq] * LOG2E, wsf, lane);
                    }
                    __syncthreads();
                }
#ifdef DUP_SWA
                }
#endif
#endif
#endif
                GRID_SYNC();
#ifndef SKIP_FOX
#ifdef DUP_FOX
#pragma unroll 1
                for (int rep_ = 0; rep_ < 2; ++rep_) {
#endif
#if FOX_ROWMAJOR_V
                {
                    PH_BEGIN();
                    static_assert(attn_body::ATTN_LDS_BYTES <= 131072 && attn_body::ATTN_PITCH == 256, "attention body geometry");
                    float skipTH;
                    { const float* cw = (const float*)(w + WS_CONST) + l * 256; float mq = fabsf(cw[128 + lane]), mk = fabsf(cw[192 + lane]);
#pragma unroll
                        for (int o = 1; o < 64; o <<= 1) { mq = fmaxf(mq, __shfl_xor(mq, o)); mk = fmaxf(mk, __shfl_xor(mk, o)); }
                        skipTH = (104.0f + 2.0f * (8.0f * mq * mk * 1.02f)) * LOG2E + 2.0f; }
#ifdef NO_SKIP
                    skipTH = 1e30f;
#endif
                    const attn_body::AttnTensors AT{(const attn_body::bf16*)(w + WS_R1 + R_FQ), (const attn_body::bf16*)(w + WS_R1 + R_FK), (const attn_body::bf16*)(w + WS_R1 + R_FV),
                                                    (attn_body::bf16*)GOUT + (size_t)3 * M * 256, (const float*)(w + WS_FC), skipTH};
#if DYNQ
                    {
                        volatile LAS unsigned* qslot = (volatile LAS unsigned*)((LAS unsigned char*)lds + 131072 + 320) + 13;
                        unsigned* qctr = (unsigned*)(w + WS_CTL) + 8192 + 64 * (2 + l);
#pragma unroll 1
                        for (;;) {
                            if (tid == 0) *qslot = __hip_atomic_fetch_add(qctr, 1u, __ATOMIC_RELAXED, __HIP_MEMORY_SCOPE_AGENT);
                            __syncthreads();
                            const int it0 = __builtin_amdgcn_readfirstlane((int)*qslot);
                            __syncthreads();
                            if (it0 >= 512) break;
                            const int bh = it0 & 15, qb = 31 - (it0 >> 4);
                            attn_body::attn_unit<48>(bh >> 2, bh & 3, qb, AT.Q, AT.K, AT.V, AT.O, AT.Fc, AT.skipTH, (char*)lds, tid);
                        }
                    }
#else
                    const attn_body::StaticOrder S(G, bid);
                    attn_body::attn_phase<attn_body::StaticOrder>((char*)lds, AT, S, tid);
#endif
                    __syncthreads();
                }
#else
                {
                    PH_BEGIN();
                    float* wsf = (float*)lds + wave * 64;
                    const bf16_t* r1 = (const bf16_t*)(w + WS_R1);
#pragma unroll 1
                    for (int pu = gw; pu < 2048; pu += ngw) {
                        const int bh = pu >> 7, pr = pu & 127, b = bh >> 2, h = bh & 3;
#pragma unroll 1
                        for (int e = 0; e < 2; ++e) { const int qblk = e ? 255 - pr : pr;
                            attn_wave_unit<1>(r1 + R_FQ / 2 + (size_t)b * SEQ * 256 + h * 64, 256, r1 + R_FK / 2 + (size_t)b * SEQ * 256 + h * 64, 256,
                                              r1 + R_FV / 2 + (size_t)bh * 64 * SEQ, (bf16_t*)GOUT + (size_t)3 * M * 256 + (size_t)b * SEQ * 256 + h * 64, qblk * 32,
                                              (const float*)(w + WS_FC) + (size_t)bh * SEQ, nullptr, 0.f, wsf, lane); }
                    }
                    __syncthreads();
                }
#endif
#ifdef DUP_FOX
                }
#endif
#endif
#if DYNQ
                {
                    PH_BEGIN();
                    float* btab = (float*)(lds + LDS_RS);
                    float* wsf = (float*)(lds + LDS_RS + 4096) + wave * 64;
                    for (int e = tid; e < 4 * 192; e += NTHR) { const int h = e / 192, dist = e % 192 - 32; float v = -1e30f;
                        if (dist >= 0 && dist < 128) { int bucket = dist;
                            if (dist >= 16) { bucket = 16 + (int)(logf((float)dist / 16.0f) / 2.0794415416798357f * 16.0f); bucket = bucket > 31 ? 31 : bucket; }
                            v = GIN(1)[bucket * 4 + h] * LOG2E; }
                        btab[e] = v; }
                    volatile LAS unsigned* qslot = (volatile LAS unsigned*)((LAS unsigned char*)lds + 131072 + 320) + 12;
                    unsigned* qctr = (unsigned*)(w + WS_CTL) + 8192 + 64 * l;
                    const bf16_t* r1 = (const bf16_t*)(w + WS_R1);
                    __syncthreads();
#pragma unroll 1
                    for (;;) {
                        if (tid == 0) *qslot = __hip_atomic_fetch_add(qctr, 1u, __ATOMIC_RELAXED, __HIP_MEMORY_SCOPE_AGENT);
                        __syncthreads();
                        const int it = __builtin_amdgcn_readfirstlane((int)*qslot);
                        __syncthreads();
                        if (it >= 512 + 512 + 256) break;
                        if (it < 512) {
                            conformer_unit(it, (const bf16_t*)(w + WS_R1 + R_U), GIN(9) + l * 31 * 256, GIN(10) + l * 256, GIN(11) + l * 256, GIN(12) + l * 256, (bf16_t*)GOUT  , lds, tid, wave, lane);
                        } else if (it < 1024) {
                            const int u = (it - 512) * 8 + wave, qblk = u & 255, hq = (u >> 8) & 3, b = u >> 10, kvh = hq >> 1;
                            attn_wave_unit<0>(r1 + R_AQ / 2 + (size_t)b * SEQ * 256 + hq * 64, 256, r1 + R_AK / 2 + (size_t)b * SEQ * 128 + kvh * 64, 128,
                                              r1 + R_AVT / 2 + (size_t)(b * 2 + kvh) * 64 * SEQ, (bf16_t*)GOUT + (size_t)2 * M * 256 + (size_t)b * SEQ * 256 + hq * 64, qblk * 32,
                                              nullptr, btab + hq * 192, GIN(18)[l * 4 + hq] * LOG2E, wsf, lane);
                        } else {
                            shortconv_all((const bf16_t*)(w + WS_R1 + R_SCX), (const bf16_t*)(w + WS_R1 + R_SB), GIN(14) + l * 3 * 256, (bf16_t*)GOUT + (size_t)M * 256  , (it - 1024) * NTHR + tid, (M / 8) * 32);
                        }
                    }
                }
#endif
                GRID_SYNC();
#ifndef SKIP_MERGE
#ifdef DUP_MERGE
#pragma unroll 1
                for (int rep_ = 0; rep_ < 2; ++rep_) {
#endif
#if MERGE_4PASS
#define MERGE_ONE(I) { PH_BEGIN(); pg8::StaticOrder S; S.init(M, D, G, bid); \
                    pg8::Gemm g{(const bf16_t*)(w + WS_XB) + (size_t)I * M * 256, (const bf16_t*)(w + WS_W + W_BR) + (size_t)I * 1024 * 256, M, D, 256}; \
                    pg8::EpiMerge<I> E{w}; pg8::gemm_phase<pg8::EpiMerge<I>, pg8::StaticOrder, true, true>(lds3, g, S, E, tid); }
                MERGE_ONE(0) MERGE_ONE(1) MERGE_ONE(2) MERGE_ONE(3)
#else
                {
                    PH_BEGIN();
                    pg8::MergeOrder S; S.base.init(M, D, G, bid);
                    pg8::Gemm g{(const bf16_t*)GOUT, (const bf16_t*)(w + WS_W + W_BR), 4 * M, 4 * D, 256};
                    pg8::EpiMergeH E{w};
                    pg8::gemm_phase<pg8::EpiMergeH, pg8::MergeOrder, true, true>(lds3, g, S, E, tid);
                }
#endif
#ifdef DUP_MERGE
                }
#endif
#endif
            }
            GRID_SYNC();
#ifndef SKIP_RESID
#ifdef DUP_RESID
#pragma unroll 1
            for (int rep_ = 0; rep_ < 2; ++rep_) {
            {
                PH_BEGIN();
                const bool last = (l == 1 && j == 2);
                const bf16_t* A = (const bf16_t*)(w + (j == 1 ? WS_R1 : WS_G));
                const bf16_t* Bt = (const bf16_t*)(w + WS_W + (j == 0 ? W_1D : j == 1 ? W_OUT : W_2D));
                pg8::Gemm g{A, Bt, M, D, j == 1 ? D : DFF};
                pg8::StaticOrder S; S.init(M, D, G, bid);
                pg8::EpiResid E{(l == 0 && j == 0 && rep_ == 0) ? GIN(0) : GOUT, GOUT, last ? nullptr : (bf16_t*)(w + WS_XB), last ? nullptr : (float*)(w + WS_SSP), (j == 1 ? 1.0f : 0.5f) * 0.5f};
                pg8::gemm_phase<pg8::EpiResid, pg8::StaticOrder, true, true>(lds3, g, S, E, tid);
            }
            }
#else
            {
                PH_BEGIN();
                const bool last = (l == 1 && j == 2);
                const bf16_t* A = (const bf16_t*)(w + (j == 1 ? WS_R1 : WS_G));
                const bf16_t* Bt = (const bf16_t*)(w + WS_W + (j == 0 ? W_1D : j == 1 ? W_OUT : W_2D));
                pg8::Gemm g{A, Bt, M, D, j == 1 ? D : DFF};
                pg8::StaticOrder S; S.init(M, D, G, bid);
                bf16_t* xbp = (bf16_t*)(w + WS_XB);
                pg8::EpiResid E{xbp, last ? nullptr : xbp, nullptr, last ? GOUT : nullptr, last ? nullptr : (float*)(w + WS_SSP), j == 1 ? 1.0f : 0.5f};
                pg8::gemm_phase<pg8::EpiResid, pg8::StaticOrder, true, true>(lds3, g, S, E, tid);
            }
#endif
#endif
            GRID_SYNC();
        }
    }
}

extern "C" void kernel_launch(void* const* d_in, const int* in_sizes, int n_in, void* d_out, int out_size, void* d_ws, size_t ws_size, hipStream_t stream) {
    static int grid = 0;
    if (grid == 0) {
        if (n_in != 28 || in_sizes[0] != M * D || out_size != M * D || ws_size < WS_END) { fprintf(stderr, "kernel_launch: unexpected shapes / workspace (n_in %d, ws %zu)\n", n_in, ws_size); grid = -1; return; }
        int dev = 0, cus = 0, per_cu = 0;
        if (hipGetDevice(&dev) != hipSuccess || hipDeviceGetAttribute(&cus, hipDeviceAttributeMultiprocessorCount, dev) != hipSuccess) { grid = -1; return; }
        if (hipFuncSetAttribute((const void*)fwd_kernel, hipFuncAttributeMaxDynamicSharedMemorySize, LDS_BYTES) != hipSuccess) { fprintf(stderr, "kernel_launch: hipFuncSetAttribute failed\n"); grid = -1; return; }
        if (hipOccupancyMaxActiveBlocksPerMultiprocessor(&per_cu, (const void*)fwd_kernel, NTHR, LDS_BYTES) != hipSuccess || per_cu < 1) { fprintf(stderr, "kernel_launch: occupancy query says %d\n", per_cu); per_cu = 1; }
        (void)hipGetLastError();
        grid = cus;
    }
    if (grid < 0) return;
    (void)hipMemsetAsync((char*)d_ws + WS_CTL, 0, CTL_ZERO_BYTES, stream);
    Params p{};
    for (int i = 0; i < 28; ++i) p.in[i] = (const float*)d_in[i];
    p.out = (float*)d_out; p.ws = (unsigned char*)d_ws;
    void* args[] = {&p};
    hipError_t e = hipLaunchCooperativeKernel((const void*)fwd_kernel, dim3(grid), dim3(NTHR), args, LDS_BYTES, stream);
    if (e != hipSuccess) fprintf(stderr, "kernel_launch: cooperative launch failed: %s\n", hipGetErrorString(e));
}
```

```cpp
#include <hip/hip_runtime.h>
#include <hip/hip_cooperative_groups.h>
#include <cstdio>
#include <cstdint>
constexpr int D = 1024, BATCH = 4, SEQ = 8192, M = BATCH * SEQ, DFF = 2816, INC = 6660, NWIN = 6656;
constexpr float EPS = 1e-6f, LOG2E = 1.4426950408889634f;
constexpr int NWAVES = 8, NTHR = 512;
constexpr int LDS_BYTES = 149504;
constexpr int LDS_RS = 131072 + 1024;
constexpr size_t MiB = 1u << 20;
constexpr size_t WS_CTL = 0, CTL_ZERO_BYTES = 2 * MiB;
constexpr size_t WS_SS = 1 * MiB;
constexpr size_t WS_LF = 2 * MiB, WS_FC = 2 * MiB + 512 * 1024;
constexpr size_t WS_CONST = 3 * MiB;
constexpr size_t WS_W = 4 * MiB;
constexpr size_t W_1GU = 0, W_1D = 11 * MiB, W_IN = 16 * MiB + 512 * 1024, W_BR = W_IN + 13 * MiB, W_OUT = W_BR + 2 * MiB, W_2GU = W_OUT + 2 * MiB, W_2D = W_2GU + 11 * MiB;
constexpr size_t WS_XB = 54 * MiB;
constexpr size_t WS_R1 = 118 * MiB;
constexpr size_t R_U = 0, R_SCX = 16 * MiB, R_SB = 32 * MiB, R_AQ = 48 * MiB, R_AK = 64 * MiB, R_AVT = 72 * MiB, R_FQ = 80 * MiB, R_FK = 96 * MiB, R_FV = 112 * MiB;
constexpr size_t WS_G = 246 * MiB;
constexpr size_t WS_SSP = 502 * MiB;
constexpr size_t WS_END = 504 * MiB;
static_assert(W_2D + (size_t)1024 * 2816 * 2 <= 50 * MiB, "weights map");
#ifndef FOX_ROWMAJOR_V
#define FOX_ROWMAJOR_V 1
#endif
#ifndef MERGE_4PASS
#define MERGE_4PASS 0
#endif
#define GAS __attribute__((address_space(1)))
#ifndef DYNQ
#define DYNQ 1
#endif
namespace pg8 {
#define PG8_LAS __attribute__((address_space(3)))
typedef unsigned short bf16_t;
typedef short bf16x8 __attribute__((ext_vector_type(8)));
typedef float f32x4 __attribute__((ext_vector_type(4)));
typedef unsigned u32x4 __attribute__((ext_vector_type(4)));
constexpr int BM = 256, BK = 64, HALF = 128, HTB = HALF * BK * 2  , STAGE_BYTES = 8 * HTB, NXCD = 8, WGM = 8;

__host__ __device__ __forceinline__ int lds_byte(int r, int c) { const int st = (r >> 4) * 2 + (c >> 5), rr = r & 15, cc = c & 31, ob = rr * 64 + cc * 2; return st * 1024 + (ob ^ (((ob >> 9) & 1) << 5)); }
__host__ __device__ __forceinline__ void stage_rc(int b, int& R, int& C) { const int st = b / 1024, sb = b % 1024, swz = sb ^ (((sb >> 9) & 1) << 5); R = (st >> 1) * 16 + swz / 64; C = (st & 1) * 32 + (swz % 64) / 2; }
__host__ __device__ __forceinline__ int perm32(int rho) { const int n = rho >> 4, i = rho & 15; return 8 * (i >> 2) + 4 * n + (i & 3); }

struct Unit { int pm, pn; };
struct Gemm { const bf16_t* A; const bf16_t* Bt; int M, N, K; };

struct StaticOrder {
    int nM, nN, nwg, G, c;
    __host__ __device__ void init(int M, int N, int G_, int c_) { nM = M / BM; nN = N / BM; nwg = nM * nN; G = G_; c = c_; }
    __host__ __device__ bool next(int i, Unit& u) const {
        const long L = (long)i * G + c; if (L >= nwg) return false;
        int wgid = (int)L; { const int q = nwg / NXCD, r = nwg % NXCD, xcd = wgid % NXCD, off = wgid / NXCD; wgid = (xcd < r ? xcd * (q + 1) : r * (q + 1) + (xcd - r) * q) + off; }
        const int nig = WGM * nN, gid = wgid / nig, fm = gid * WGM, gsz = (nM - fm) < WGM ? (nM - fm) : WGM;
        u.pm = fm + ((wgid % nig) % gsz); u.pn = (wgid % nig) / gsz; return true;
    }
    __device__ __forceinline__ void a_ready(const Unit&) const {}
    __device__ __forceinline__ void done(const Unit&) const {}
};

__device__ __forceinline__ unsigned cvt_pk_bf16(float lo, float hi) { unsigned r; asm volatile("v_cvt_pk_bf16_f32 %0, %1, %2" : "=v"(r) : "v"(lo), "v"(hi)); return r; }
typedef float f32x2 __attribute__((ext_vector_type(2)));
constexpr int P_D = 1024, P_SEQ = 8192, P_DFF = 2816;
constexpr float P_EPS = 1e-6f;
constexpr float P_QSCALE = 0.125f * 1.4426950408889634f;
__device__ __forceinline__ float fsigmoid(float x) { return __builtin_amdgcn_rcpf(1.0f + __expf(-x)); }
__device__ __forceinline__ float fsilu(float x) { return x * fsigmoid(x); }
__device__ __forceinline__ float rs_row(const float* ssp, int row) { const f32x4* q = (const f32x4*)(ssp + (size_t)row * 16); const f32x4 a = q[0], b = q[1], c = q[2], d = q[3];
    const float s = (((a[0] + a[1]) + (a[2] + a[3])) + ((b[0] + b[1]) + (b[2] + b[3]))) + (((c[0] + c[1]) + (c[2] + c[3])) + ((d[0] + d[1]) + (d[2] + d[3])));
    return rsqrtf(s * (1.0f / 1024.0f) + P_EPS); }
template <int NB> __device__ __forceinline__ void rs_rows8(const float* ssp, int row0, float (&rs)[8]) {
#pragma unroll
    for (int b0 = 0; b0 < 8; b0 += NB) {
        f32x4 q[NB][4];
#pragma unroll
        for (int j = 0; j < NB; ++j) { const int r = b0 + j; const f32x4* p = (const f32x4*)(ssp + (size_t)(row0 + (r >> 2) * HALF + (r & 3) * 16) * 16);
#pragma unroll
            for (int k = 0; k < 4; ++k) q[j][k] = p[k]; }
#pragma unroll
        for (int j = 0; j < NB; ++j) { const f32x4 a = q[j][0], b = q[j][1], c = q[j][2], d = q[j][3];
            const float s = (((a[0] + a[1]) + (a[2] + a[3])) + ((b[0] + b[1]) + (b[2] + b[3]))) + (((c[0] + c[1]) + (c[2] + c[3])) + ((d[0] + d[1]) + (d[2] + d[3])));
            rs[b0 + j] = rsqrtf(s * (1.0f / 1024.0f) + P_EPS); }
        asm volatile("" ::: "memory");
    }
}
__device__ __forceinline__ void rs_rows8w(const float* ssp, int rowbase  , int fr, int fq, float (&rs)[8]) {
    const int lane = fr + 16 * fq; f32x4 q[2][4]; float r[2];
#pragma unroll
    for (int h = 0; h < 2; ++h) { const f32x4* p = (const f32x4*)(ssp + (size_t)(rowbase + h * HALF + lane) * 16);
#pragma unroll
        for (int k = 0; k < 4; ++k) q[h][k] = p[k]; }
#pragma unroll
    for (int h = 0; h < 2; ++h) { const f32x4 a = q[h][0], b = q[h][1], c = q[h][2], d = q[h][3];
        const float s = (((a[0] + a[1]) + (a[2] + a[3])) + ((b[0] + b[1]) + (b[2] + b[3]))) + (((c[0] + c[1]) + (c[2] + c[3])) + ((d[0] + d[1]) + (d[2] + d[3])));
        r[h] = rsqrtf(s * (1.0f / 1024.0f) + P_EPS); }
#pragma unroll
    for (int ai = 0; ai < 2; ++ai)
#pragma unroll
        for (int m = 0; m < 4; ++m) rs[ai * 4 + m] = __shfl(r[ai], 16 * m + fr);
    asm volatile("" ::: "memory");
}
__device__ __forceinline__ void rs_rows8l(PG8_LAS const float* grp  , int fr, int fq, float (&rs)[8]) {
    const int lane = fr + 16 * fq; f32x4 q[2][4]; float r[2];
#pragma unroll
    for (int h = 0; h < 2; ++h) { PG8_LAS const f32x4* p = (PG8_LAS const f32x4*)(grp + (h * 64 + lane) * 16);
#pragma unroll
        for (int k = 0; k < 4; ++k) q[h][k] = p[k]; }
#pragma unroll
    for (int h = 0; h < 2; ++h) { const f32x4 a = q[h][0], b = q[h][1], c = q[h][2], d = q[h][3];
        const float s = (((a[0] + a[1]) + (a[2] + a[3])) + ((b[0] + b[1]) + (b[2] + b[3]))) + (((c[0] + c[1]) + (c[2] + c[3])) + ((d[0] + d[1]) + (d[2] + d[3])));
        r[h] = rsqrtf(s * (1.0f / 1024.0f) + P_EPS); }
#pragma unroll
    for (int ai = 0; ai < 2; ++ai)
#pragma unroll
        for (int m = 0; m < 4; ++m) rs[ai * 4 + m] = __shfl(r[ai], 16 * m + fr);
}
__device__ __forceinline__ void store8(bf16_t* p, const f32x4 a, const f32x4 b) {
    u32x4 w; w.x = cvt_pk_bf16(a[0], a[1]); w.y = cvt_pk_bf16(a[2], a[3]); w.z = cvt_pk_bf16(b[0], b[1]); w.w = cvt_pk_bf16(b[2], b[3]);
    *(GAS u32x4*)p = w;
}
__device__ __forceinline__ f32x4 bf_lo4(unsigned a, unsigned b) { return (f32x4){__uint_as_float(a << 16), __uint_as_float(a & 0xffff0000u), __uint_as_float(b << 16), __uint_as_float(b & 0xffff0000u)}; }
__device__ __forceinline__ unsigned short f2bf1(float f) { unsigned u = __float_as_uint(f); return (unsigned short)((u + 0x7fffu + ((u >> 16) & 1u)) >> 16); }

struct EpiSwiglu {
    static constexpr bool PERM = true, AFTER_DRAIN = false, KEEP = false, PREFETCH = false, RSDMA = true;
    unsigned char* ws; const float* ss; PG8_LAS const float* rsl;
    __device__ __forceinline__ const float* rs_src() const { return ss; }
    __device__ __forceinline__ void operator()(const f32x4 (&acc)[2][2][4][2], const Unit& u, int wr, int wc, int fr, int fq) const {
        const int row0 = u.pm * BM + wr * 64 + fr, col = u.pn * 128 + wc * 32 + 8 * fq; bf16_t* act = (bf16_t*)(ws + WS_G);
        float rsv[8]; rs_rows8l(rsl + wr * 2048, fr, fq, rsv);
#pragma unroll
        for (int ai = 0; ai < 2; ++ai)
#pragma unroll
            for (int m = 0; m < 4; ++m) {
                const int row = row0 + ai * HALF + m * 16; const float rs = rsv[ai * 4 + m], rsg = rs * 1.4426950408889634f, rsu = rs * 0.6931471805599453f;
                f32x4 o[2];
#pragma unroll
                for (int n = 0; n < 2; ++n) {
                    const f32x4 g2 = acc[ai][0][m][n] * rsg, u2 = acc[ai][1][m][n] * rsu;
                    f32x4 ex;
#pragma unroll
                    for (int i = 0; i < 4; ++i) ex[i] = __builtin_amdgcn_exp2f(fminf(-g2[i], 28.853900817779268f));
                    ex = ex + 1.0f;
                    const float a = ex[0] * ex[1], b = ex[2] * ex[3], r = __builtin_amdgcn_rcpf(a * b), ra = r * b, rb = r * a;
                    const f32x4 inv = (f32x4){ex[1], ex[0], ex[3], ex[2]} * (f32x4){ra, ra, rb, rb};
                    o[n] = (g2 * inv) * u2; }
                store8(act + (size_t)row * P_DFF + col, o[0], o[1]);
                asm volatile("" ::: "memory");
            }
    }
};
struct EpiResid {
    static constexpr bool PERM = true, AFTER_DRAIN = false, KEEP = false, PREFETCH = false, RSDMA = false;
    const bf16_t* xin; bf16_t* xb; bf16_t* xs; float* xout; float* ssn; float scale;
    __device__ __forceinline__ void operator()(const f32x4 (&acc)[2][2][4][2], const Unit& u, int wr, int wc, int fr, int fq) const {
        const int row0 = u.pm * BM + wr * 64 + fr, col0 = u.pn * BM + wc * 32 + 8 * fq;
        u32x4 xv[4][2][2];
#define RESID_LOAD(q) do { _Pragma("unroll") for (int mm = 0; mm < 2; ++mm) _Pragma("unroll") for (int bj = 0; bj < 2; ++bj) \
            xv[q][mm][bj] = *(const GAS u32x4*)(xin + (size_t)(row0 + ((q) >> 1) * HALF + (((q) & 1) * 2 + mm) * 16) * P_D + col0 + bj * HALF); } while (0)
        RESID_LOAD(0); RESID_LOAD(1); RESID_LOAD(2);
#pragma unroll
        for (int q = 0; q < 4; ++q) {
            if (q == 1) RESID_LOAD(3);
            const int ai = q >> 1;
#pragma unroll
            for (int mm = 0; mm < 2; ++mm) {
                const int m = (q & 1) * 2 + mm, row = row0 + ai * HALF + m * 16; float part = 0.f;
#pragma unroll
                for (int bj = 0; bj < 2; ++bj) {
                    const size_t off = (size_t)row * P_D + col0 + bj * HALF;
                    const f32x4 n0 = bf_lo4(xv[q][mm][bj].x, xv[q][mm][bj].y) + acc[ai][bj][m][0] * scale, n1 = bf_lo4(xv[q][mm][bj].z, xv[q][mm][bj].w) + acc[ai][bj][m][1] * scale;
                    if (xout) { *(GAS f32x4*)(xout + off) = n0; *(GAS f32x4*)(xout + off + 4) = n1; }
                    if (xb) store8(xb + off, n0, n1);
                    if (xs) store8(xs + off, n0, n1);
                    part += (n0[0] * n0[0] + n0[1] * n0[1]) + (n0[2] * n0[2] + n0[3] * n0[3]) + (n1[0] * n1[0] + n1[1] * n1[1]) + (n1[2] * n1[2] + n1[3] * n1[3]);
                }
                part += __shfl_xor(part, 16); part += __shfl_xor(part, 32);
                if (ssn && fq == 0) *(GAS float*)(ssn + (size_t)row * 16 + u.pn * 4 + wc) = part;
            }
        }
#undef RESID_LOAD
        asm volatile("" ::: "memory");
    }
};
struct EpiWin {
    static constexpr bool PERM = true, AFTER_DRAIN = false, KEEP = false, PREFETCH = false, RSDMA = true;
    unsigned char* ws; const float* ss; int l; PG8_LAS const float* rsl;
    __device__ __forceinline__ const float* rs_src() const { return ss; }
    __device__ __forceinline__ void operator()(const f32x4 (&acc)[2][2][4][2], const Unit& u, int wr, int wc, int fr, int fq) const {
        const int pn = u.pn, row0 = u.pm * BM + wr * 64 + fr;
        float rsv[8]; rs_rows8l(rsl + wr * 2048, fr, fq, rsv);
        unsigned char* r1 = ws + WS_R1;
        bf16_t *U = (bf16_t*)(r1 + R_U), *SCX = (bf16_t*)(r1 + R_SCX), *SB = (bf16_t*)(r1 + R_SB), *AQ = (bf16_t*)(r1 + R_AQ), *AK = (bf16_t*)(r1 + R_AK), *AVt = (bf16_t*)(r1 + R_AVT),
               *FQ = (bf16_t*)(r1 + R_FQ), *FK = (bf16_t*)(r1 + R_FK), *FV = FOX_ROWMAJOR_V ? (bf16_t*)(r1 + R_FV) : nullptr, *FVt = FOX_ROWMAJOR_V ? nullptr : (bf16_t*)(r1 + R_FV), *G = (bf16_t*)(ws + WS_G);
        const float* cw = (const float*)(ws + WS_CONST) + l * 256; const float *gq_swa = cw, *gk_swa = cw + 64, *gq_fox = cw + 128, *gk_fox = cw + 192;
        if (pn < 4) {
            bf16_t* dst = pn < 2 ? U : SCX; const int cb = (pn & 1) * 128 + wc * 32 + 8 * fq;
#pragma unroll
            for (int ai = 0; ai < 2; ++ai)
#pragma unroll
                for (int m = 0; m < 4; ++m) {
                    const int row = row0 + ai * HALF + m * 16; const float rs = rsv[ai * 4 + m];
                    f32x4 o[2];
#pragma unroll
                    for (int n = 0; n < 2; ++n) { const f32x4 a = acc[ai][0][m][n] * rs, b = acc[ai][1][m][n] * rs;
#pragma unroll
                        for (int i = 0; i < 4; ++i) o[n][i] = pn < 2 ? a[i] * fsigmoid(b[i]) : a[i] * b[i]; }
                    store8(dst + (size_t)row * 256 + cb, o[0], o[1]);
                    asm volatile("" ::: "memory");
                }
        } else if (pn == 4) {
#pragma unroll
            for (int ai = 0; ai < 2; ++ai)
#pragma unroll
                for (int m = 0; m < 4; ++m) {
                    const int row = row0 + ai * HALF + m * 16; const float rs = rsv[ai * 4 + m];
#pragma unroll
                    for (int bj = 0; bj < 2; ++bj) store8(SB + (size_t)row * 256 + bj * HALF + wc * 32 + 8 * fq, acc[ai][bj][m][0] * rs, acc[ai][bj][m][1] * rs);
                    asm volatile("" ::: "memory");
                }
        } else if (pn >= 10) {
            const int c0 = 64 * (pn - 10) + 16 * wc + 4 * fq;
#pragma unroll
            for (int ai = 0; ai < 2; ++ai)
#pragma unroll
                for (int m = 0; m < 4; ++m) {
                    const int row = row0 + ai * HALF + m * 16; const float rs = rsv[ai * 4 + m];
                    const float rsl = -rs * 1.4426950408889634f;
                    f32x4 e0 = acc[ai][0][m][0] * rsl, e1 = acc[ai][0][m][1] * rsl, e2 = acc[ai][1][m][0] * rsl, e3 = acc[ai][1][m][1] * rsl;
#pragma unroll
                    for (int i = 0; i < 4; ++i) { e0[i] = __builtin_amdgcn_exp2f(fminf(e0[i], 28.853900817779268f)); e1[i] = __builtin_amdgcn_exp2f(fminf(e1[i], 28.853900817779268f));
                                                  e2[i] = __builtin_amdgcn_exp2f(fminf(e2[i], 28.853900817779268f)); e3[i] = __builtin_amdgcn_exp2f(fminf(e3[i], 28.853900817779268f)); }
                    e0 = e0 + 1.0f; e1 = e1 + 1.0f; e2 = e2 + 1.0f; e3 = e3 + 1.0f;
                    const f32x4 a = e0 * e1, b = e2 * e3, ab = a * b; f32x4 r;
#pragma unroll
                    for (int i = 0; i < 4; ++i) r[i] = __builtin_amdgcn_rcpf(ab[i]);
                    const f32x4 ra = r * b, rb = r * a;
                    const f32x4 s0 = (ra * e1) * e1, s1 = (ra * e0) * e2, s2 = (rb * e3) * e3, s3 = rb * e2;
                    bf16_t* gp = G + (size_t)row * 4096 + c0;
                    *(GAS unsigned long long*)(gp) = (unsigned long long)cvt_pk_bf16(s0[0], s0[1]) | ((unsigned long long)cvt_pk_bf16(s0[2], s0[3]) << 32);
                    *(GAS unsigned long long*)(gp + 1024) = (unsigned long long)cvt_pk_bf16(s1[0], s1[1]) | ((unsigned long long)cvt_pk_bf16(s1[2], s1[3]) << 32);
                    *(GAS unsigned long long*)(gp + 2048) = (unsigned long long)cvt_pk_bf16(s2[0], s2[1]) | ((unsigned long long)cvt_pk_bf16(s2[2], s2[3]) << 32);
                    *(GAS unsigned long long*)(gp + 3072) = (unsigned long long)cvt_pk_bf16(s3[0], s3[1]) | ((unsigned long long)cvt_pk_bf16(s3[2], s3[3]) << 32);
                    asm volatile("" ::: "memory");
                }
        } else {
            const bool is_vt = (pn == 9) || (pn == 6 && wc >= 2);
            if (!is_vt) {
                const float* gw = pn == 5 ? gq_swa : pn == 6 ? gk_swa : pn == 7 ? gq_fox : gk_fox;
                const float sc = (pn == 5 || pn == 7) ? P_QSCALE : 1.0f;
                bf16_t* dst = pn == 5 ? AQ : pn == 6 ? AK : pn == 7 ? FQ : FK; const int ld = pn == 6 ? 128 : 256;
                f32x4 gv[2][2];
#pragma unroll
                for (int bj = 0; bj < 2; ++bj)
#pragma unroll
                    for (int n = 0; n < 2; ++n) gv[bj][n] = *(const GAS f32x4*)(gw + 32 * bj + 8 * fq + 4 * n) * sc;
#pragma unroll
                for (int ai = 0; ai < 2; ++ai)
#pragma unroll
                    for (int m = 0; m < 4; ++m) {
                        const int row = row0 + ai * HALF + m * 16; const float rs = rsv[ai * 4 + m];
                        f32x4 v[2][2]; float q = 0.f;
#pragma unroll
                        for (int bj = 0; bj < 2; ++bj)
#pragma unroll
                            for (int n = 0; n < 2; ++n) { v[bj][n] = acc[ai][bj][m][n] * rs; const f32x4 t = v[bj][n]; q += (t[0] * t[0] + t[1] * t[1]) + (t[2] * t[2] + t[3] * t[3]); }
                        q += __shfl_xor(q, 16); q += __shfl_xor(q, 32);
                        const float r = rsqrtf(q * (1.0f / 64.0f) + P_EPS);
#pragma unroll
                        for (int bj = 0; bj < 2; ++bj) store8(dst + (size_t)row * ld + wc * 64 + 32 * bj + 8 * fq, v[bj][0] * r * gv[bj][0], v[bj][1] * r * gv[bj][1]);
                        asm volatile("" ::: "memory");
                    }
            } else {
                const int H = pn == 9 ? 4 : 2, head = pn == 9 ? wc : wc - 2; bf16_t* dst = pn == 9 ? FVt : AVt;
#pragma unroll
                for (int ai = 0; ai < 2; ++ai)
#pragma unroll
                    for (int m = 0; m < 4; ++m) {
                        const int row = row0 + ai * HALF + m * 16; const float rs = rsv[ai * 4 + m];
                        const int b = row / P_SEQ, t = row % P_SEQ;
#pragma unroll
                        for (int bj = 0; bj < 2; ++bj) {
                            const f32x4 a0 = acc[ai][bj][m][0] * rs, a1 = acc[ai][bj][m][1] * rs;
                            if (dst) { bf16_t* base = dst + ((size_t)(b * H + head) * 64 + 32 * bj + 8 * fq) * P_SEQ + t;
#pragma unroll
                                for (int i = 0; i < 4; ++i) { *(GAS bf16_t*)(base + (size_t)i * P_SEQ) = f2bf1(a0[i]); *(GAS bf16_t*)(base + (size_t)(4 + i) * P_SEQ) = f2bf1(a1[i]); } }
                            if (pn == 9 && FV) store8(FV + (size_t)row * 256 + wc * 64 + 32 * bj + 8 * fq, a0, a1);
                        }
                        asm volatile("" ::: "memory");
                    }
            }
        }
    }
};
template <int I> struct EpiMerge {
    static constexpr bool PERM = true, AFTER_DRAIN = false, KEEP = false, PREFETCH = false, RSDMA = false;
    unsigned char* ws;
    __device__ __forceinline__ void operator()(const f32x4 (&acc)[2][2][4][2], const Unit& u, int wr, int wc, int fr, int fq) const {
        const int row0 = u.pm * BM + wr * 64 + fr, col0 = u.pn * BM + wc * 32 + 8 * fq; const bf16_t* G = (const bf16_t*)(ws + WS_G); bf16_t* Mg = (bf16_t*)(ws + WS_R1);
#pragma unroll
        for (int ai = 0; ai < 2; ++ai)
#pragma unroll
            for (int m = 0; m < 4; ++m) {
                const int row = row0 + ai * HALF + m * 16;
#pragma unroll
                for (int bj = 0; bj < 2; ++bj) {
                    const int col = col0 + bj * HALF;
                    const u32x4 g = *(const u32x4*)(G + (size_t)row * 4096 + I * 1024 + col);
                    f32x4 v0 = acc[ai][bj][m][0] * bf_lo4(g.x, g.y), v1 = acc[ai][bj][m][1] * bf_lo4(g.z, g.w);
                    bf16_t* mp = Mg + (size_t)row * P_D + col;
                    if (I > 0) { const u32x4 o = *(const u32x4*)mp; v0 += bf_lo4(o.x, o.y); v1 += bf_lo4(o.z, o.w); }
                    store8(mp, v0, v1);
                }
                asm volatile("" ::: "memory");
            }
    }
};

struct MergeOrder {
    StaticOrder base;
    __device__ __forceinline__ bool next(int i, Unit& u) const { Unit b; if (!base.next(i >> 2, b)) return false; const int br = i & 3; u.pm = b.pm + 128 * br; u.pn = b.pn + 4 * br; return true; }
    __device__ __forceinline__ void a_ready(const Unit&) const {}
    __device__ __forceinline__ void done(const Unit&) const {}
};
struct EpiMergeH {
    static constexpr bool PERM = true, AFTER_DRAIN = false, KEEP = true, PREFETCH = false, RSDMA = false;
    unsigned char* ws;
    __device__ __forceinline__ bool keep(const Unit& u) const { return (u.pm >> 7) < 3; }
    __device__ __forceinline__ void operator()(const f32x4 (&acc_)[2][2][4][2], const Unit& u, int wr, int wc, int fr, int fq) const {
        f32x4 (&acc)[2][2][4][2] = const_cast<f32x4 (&)[2][2][4][2]>(acc_);
        const int br = u.pm >> 7, pm = u.pm & 127, pn = u.pn & 3;
        const int row0 = pm * BM + wr * 64 + fr, col0 = pn * BM + wc * 32 + 8 * fq; const bf16_t* S = (const bf16_t*)(ws + WS_G) + (size_t)br * 1024 + col0; bf16_t* Mg = (bf16_t*)(ws + WS_R1) + col0;
        u32x4 gv[2][4][2];
#pragma unroll
        for (int ai = 0; ai < 2; ++ai)
#pragma unroll
            for (int m = 0; m < 4; ++m)
#pragma unroll
                for (int bj = 0; bj < 2; ++bj) gv[ai][m][bj] = *(const GAS u32x4*)(S + (size_t)(row0 + ai * HALF + m * 16) * 4096 + bj * HALF);
#pragma unroll
        for (int ai = 0; ai < 2; ++ai)
#pragma unroll
            for (int m = 0; m < 4; ++m) {
                const int row = row0 + ai * HALF + m * 16;
#pragma unroll
                for (int bj = 0; bj < 2; ++bj) {
                    const f32x4 g0 = bf_lo4(gv[ai][m][bj].x, gv[ai][m][bj].y), g1 = bf_lo4(gv[ai][m][bj].z, gv[ai][m][bj].w);
                    if (br < 3) { acc[ai][bj][m][0] *= g0; acc[ai][bj][m][1] *= g1; }
                    else store8(Mg + (size_t)row * P_D + bj * HALF, acc[ai][bj][m][0] * g0, acc[ai][bj][m][1] * g1);
                }
            }
        asm volatile("" ::: "memory");
    }
};
template <class Epi, class Sched, bool ALIGN_EPI = false, bool SP2 = false>
__device__ __forceinline__ void gemm_phase(PG8_LAS unsigned char* lds, const Gemm g, const Sched& S, const Epi& E, const int tid_in) {
    int tid_ = tid_in; asm volatile("" : "+v"(tid_));
    const int tid = tid_, wid = __builtin_amdgcn_readfirstlane(tid >> 6), lane = tid & 63, wr = wid >> 2, wc = wid & 3, fr = lane & 15, fq = lane >> 4;
    const int K = g.K, nt = K / BK;
    unsigned voffA[2], voffB[2];
#pragma unroll
    for (int i = 0; i < 2; ++i) { int R, C; stage_rc(tid * 16 + i * 8192, R, C); const int Rb = Epi::PERM ? ((R & ~31) + perm32(R & 31)) : R;
        voffA[i] = (unsigned)(R * K + C) * 2u; voffB[i] = (unsigned)(Rb * K + C) * 2u; }
    const size_t kstep = (size_t)(BK * 2);
    const size_t hstep = (size_t)HALF * K * 2;
    const size_t tstep = 2 * hstep;
    const unsigned ldsw = (unsigned)wid * 1024u;
    const int aoff = lds_byte(wr * 64 + fr, fq * 8), boff = lds_byte(wc * 32 + fr, fq * 8);
#define PG8_SA(b, h) (((b) * 2 + (h)) * HTB)
#define PG8_SB(b, h) ((4 + (b) * 2 + (h)) * HTB)
#define PG8_STAGE(bufoff, gbase, voff) do { _Pragma("unroll") for (int _i = 0; _i < 2; ++_i) \
        __builtin_amdgcn_global_load_lds((const unsigned*)((const char*)(gbase) + (voff)[_i]), (PG8_LAS unsigned*)(lds + (bufoff) + ldsw + _i * 8192), 16, 0, 0); } while (0)
#define PG8_LDA(dst, b, h) do { _Pragma("unroll") for (int m = 0; m < 4; ++m) _Pragma("unroll") for (int k = 0; k < 2; ++k) dst[m][k] = *(const PG8_LAS bf16x8*)(lds + PG8_SA(b, h) + aoff + m * 2048 + k * 1024); } while (0)
#define PG8_LDB(dst, b, h) do { _Pragma("unroll") for (int n = 0; n < 2; ++n) _Pragma("unroll") for (int k = 0; k < 2; ++k) dst[n][k] = *(const PG8_LAS bf16x8*)(lds + PG8_SB(b, h) + boff + n * 2048 + k * 1024); } while (0)
#define PG8_MMA(ai, bj, At, Bt) do { __builtin_amdgcn_s_setprio(1); _Pragma("unroll") for (int m = 0; m < 4; ++m) _Pragma("unroll") for (int n = 0; n < 2; ++n) _Pragma("unroll") for (int k = 0; k < 2; ++k) \
        acc[ai][bj][m][n] = __builtin_amdgcn_mfma_f32_16x16x32_bf16(Bt[n][k], At[m][k], acc[ai][bj][m][n], 0, 0, 0); __builtin_amdgcn_s_setprio(0); } while (0)
#define PG8_WAIT_V(n) asm volatile("s_waitcnt vmcnt(" #n ")" ::: "memory")
#define PG8_WAIT_L(n) asm volatile("s_waitcnt lgkmcnt(" #n ")" ::: "memory")
#define PG8_BAR __builtin_amdgcn_s_barrier()
#define PG8_SCHED __builtin_amdgcn_sched_barrier(0)
    Unit cur, nxt; int ui = 0;
    if (!S.next(0, cur)) return;
    f32x4 acc[2][2][4][2];
#pragma unroll
    for (int a = 0; a < 2; ++a)
#pragma unroll
        for (int b = 0; b < 2; ++b)
#pragma unroll
            for (int m = 0; m < 4; ++m)
#pragma unroll
                for (int n = 0; n < 2; ++n) acc[a][b][m][n] = (f32x4){0.f, 0.f, 0.f, 0.f};
    bf16x8 At[4][2], B0[2][2], B1[2][2];
    const char* cA = (const char*)g.A + (size_t)cur.pm * tstep; const char* cB = (const char*)g.Bt + (size_t)cur.pn * tstep;
    S.a_ready(cur);
    if constexpr (SP2) {
        PG8_STAGE(PG8_SB(0, 0), cB, voffB); PG8_STAGE(PG8_SB(0, 1), cB + hstep, voffB); PG8_STAGE(PG8_SA(0, 0), cA, voffA); PG8_STAGE(PG8_SA(0, 1), cA + hstep, voffA);
        if (wr == 1) PG8_BAR;
        PG8_WAIT_V(2); PG8_BAR;
        PG8_STAGE(PG8_SB(1, 0), cB + kstep, voffB); PG8_STAGE(PG8_SA(1, 0), cA + kstep, voffA); PG8_STAGE(PG8_SB(1, 1), cB + hstep + kstep, voffB);
        PG8_WAIT_V(6); PG8_BAR;
    } else {
        PG8_STAGE(PG8_SB(0, 0), cB, voffB); PG8_STAGE(PG8_SA(0, 0), cA, voffA); PG8_STAGE(PG8_SB(0, 1), cB + hstep, voffB); PG8_STAGE(PG8_SA(0, 1), cA + hstep, voffA);
        if (wr == 1) PG8_BAR;
        PG8_WAIT_V(4); PG8_BAR;
        PG8_STAGE(PG8_SB(1, 0), cB + kstep, voffB); PG8_STAGE(PG8_SA(1, 0), cA + kstep, voffA); PG8_STAGE(PG8_SB(1, 1), cB + hstep + kstep, voffB);
        PG8_WAIT_V(6); PG8_BAR;
    }
#define PG8_RS_ISSUE(un) do { if constexpr (Epi::RSDMA) { if (wr == 1) { const char* gb_ = (const char*)(E.rs_src() + (size_t)(un).pm * BM * 16); \
        int l2_; asm volatile("v_mbcnt_lo_u32_b32 %0, -1, 0\n\tv_mbcnt_hi_u32_b32 %0, -1, %0" : "=v"(l2_)); \
        _Pragma("unroll") for (int j_ = 0; j_ < 4; ++j_) { const int p_ = wc * 4 + j_, g_ = p_ >> 3, r_ = (p_ & 7) * 16, tb_ = r_ < 64 ? g_ * 64 + r_ : HALF + g_ * 64 + (r_ - 64); \
            __builtin_amdgcn_global_load_lds((const unsigned*)(gb_ + (size_t)tb_ * 64 + (unsigned)l2_ * 16u), (PG8_LAS unsigned*)(lds + LDS_RS + g_ * 8192 + r_ * 64), 16, 0, 0); } } } } while (0)
    PG8_RS_ISSUE(cur);
    for (;;) {
        const bool has_next = S.next(ui + 1, nxt);
        const char* nA = has_next ? (const char*)g.A + (size_t)nxt.pm * tstep : cA; const char* nB = has_next ? (const char*)g.Bt + (size_t)nxt.pn * tstep : cB;
        for (int t = 0; t < nt; t += 2) {
            const bool last = (t == nt - 2);
            const char* a1 = cA + (size_t)(t + 1) * kstep;
            const char* a2 = last ? nA : cA + (size_t)(t + 2) * kstep; const char* b2 = last ? nB : cB + (size_t)(t + 2) * kstep;
            const char* a3 = a2 + kstep; const char* b3 = b2 + kstep;
            if (last && has_next) S.a_ready(nxt);
            if constexpr (Epi::PREFETCH) {
                if (t < 16) {
                    const char* pb = E.pf_base(cur) + (size_t)(wid * 32 + (t >> 1) * 4) * (P_D * 4) + lane * 16;
#pragma unroll
                    for (int q = 0; q < 4; ++q) __builtin_amdgcn_global_load_lds((const unsigned*)(pb + (size_t)q * (P_D * 4)), (PG8_LAS unsigned*)(lds + 131072 + 1024 + wid * 1024), 16, 0, 0);
                }
            }
            if constexpr (SP2) {
            PG8_LDB(B0, 0, 0); PG8_LDB(B1, 0, 1); PG8_SCHED; PG8_LDA(At, 0, 0); PG8_STAGE(PG8_SA(1, 1), a1 + hstep, voffA);
            PG8_WAIT_V(8); PG8_WAIT_L(0); PG8_BAR; PG8_MMA(0, 0, At, B0); PG8_MMA(0, 1, At, B1); PG8_BAR; PG8_SCHED;
            PG8_LDA(At, 0, 1); PG8_STAGE(PG8_SB(0, 0), b2, voffB); PG8_STAGE(PG8_SB(0, 1), b2 + hstep, voffB); PG8_STAGE(PG8_SA(0, 0), a2, voffA);
            PG8_WAIT_V(8); PG8_WAIT_L(0); PG8_BAR; PG8_MMA(1, 0, At, B0); PG8_MMA(1, 1, At, B1); PG8_BAR; PG8_SCHED;
            PG8_LDB(B0, 1, 0); PG8_LDB(B1, 1, 1); PG8_SCHED; PG8_LDA(At, 1, 0); PG8_STAGE(PG8_SA(0, 1), a2 + hstep, voffA);
            PG8_WAIT_V(8); PG8_WAIT_L(0); PG8_BAR; PG8_MMA(0, 0, At, B0); PG8_MMA(0, 1, At, B1); PG8_BAR; PG8_SCHED;
            PG8_LDA(At, 1, 1); PG8_STAGE(PG8_SB(1, 0), b3, voffB); PG8_STAGE(PG8_SB(1, 1), b3 + hstep, voffB); PG8_STAGE(PG8_SA(1, 0), a3, voffA);
            PG8_WAIT_V(8); PG8_WAIT_L(0); PG8_BAR; PG8_MMA(1, 0, At, B0); PG8_MMA(1, 1, At, B1); PG8_BAR; PG8_SCHED;
            } else {
            PG8_LDB(B0, 0, 0); PG8_SCHED; PG8_LDA(At, 0, 0); PG8_STAGE(PG8_SA(1, 1), a1 + hstep, voffA);
            PG8_WAIT_L(8); PG8_BAR; PG8_WAIT_L(0); PG8_MMA(0, 0, At, B0); PG8_BAR; PG8_SCHED;
            PG8_LDB(B1, 0, 1); PG8_STAGE(PG8_SB(0, 0), b2, voffB);
            PG8_BAR; PG8_WAIT_L(0); PG8_MMA(0, 1, At, B1); PG8_BAR;
            PG8_LDA(At, 0, 1); PG8_STAGE(PG8_SA(0, 0), a2, voffA);
            PG8_BAR; PG8_WAIT_L(0); PG8_MMA(1, 0, At, B0); PG8_BAR; PG8_SCHED;
            PG8_STAGE(PG8_SB(0, 1), b2 + hstep, voffB);
            PG8_WAIT_V(6); PG8_BAR; PG8_MMA(1, 1, At, B1); PG8_BAR;
            PG8_LDB(B0, 1, 0); PG8_SCHED; PG8_LDA(At, 1, 0); PG8_STAGE(PG8_SA(0, 1), a2 + hstep, voffA);
            PG8_WAIT_L(8); PG8_BAR; PG8_WAIT_L(0); PG8_MMA(0, 0, At, B0); PG8_BAR; PG8_SCHED;
            PG8_LDB(B1, 1, 1); PG8_STAGE(PG8_SB(1, 0), b3, voffB);
            PG8_BAR; PG8_WAIT_L(0); PG8_MMA(0, 1, At, B1); PG8_BAR;
            PG8_LDA(At, 1, 1); PG8_STAGE(PG8_SA(1, 0), a3, voffA);
            PG8_BAR; PG8_WAIT_L(0); PG8_MMA(1, 0, At, B0); PG8_BAR; PG8_SCHED;
            PG8_STAGE(PG8_SB(1, 1), b3 + hstep, voffB);
            PG8_WAIT_V(6); PG8_BAR; PG8_MMA(1, 1, At, B1); PG8_BAR;
            }
        }
        if constexpr (ALIGN_EPI) { if (wr == 0) PG8_BAR; }
        if constexpr (!Epi::AFTER_DRAIN) { int ln_; asm volatile("v_mbcnt_lo_u32_b32 %0, -1, 0\n\tv_mbcnt_hi_u32_b32 %0, -1, %0" : "=v"(ln_));
            E(acc, cur, wr, wc, ln_ & 15, ln_ >> 4); S.done(cur); }
        if (!has_next) break;
        bool keep_ = false; if constexpr (Epi::KEEP) keep_ = E.keep(cur);
        if (!keep_) {
#pragma unroll
        for (int a = 0; a < 2; ++a)
#pragma unroll
            for (int b = 0; b < 2; ++b)
#pragma unroll
                for (int m = 0; m < 4; ++m)
#pragma unroll
                    for (int n = 0; n < 2; ++n) acc[a][b][m][n] = (f32x4){0.f, 0.f, 0.f, 0.f};
        }
        cur = nxt; cA = nA; cB = nB; ++ui;
        if constexpr (ALIGN_EPI) { if (wr == 1) PG8_BAR; }
        PG8_RS_ISSUE(cur);
    }
    PG8_WAIT_V(0);
    if constexpr (!ALIGN_EPI) { if (wr == 0) PG8_BAR; }
    PG8_BAR;
    if constexpr (Epi::AFTER_DRAIN) { E.fused(acc, cur, wr, wc, fr, fq, lds, wid, lane); S.done(cur); }
#undef PG8_SA
#undef PG8_SB
#undef PG8_STAGE
#undef PG8_LDA
#undef PG8_LDB
#undef PG8_MMA
#undef PG8_WAIT_V
#undef PG8_WAIT_L
#undef PG8_BAR
#undef PG8_SCHED
#undef PG8_RS_ISSUE
}
}
#include <hip/hip_bf16.h>
#include <cmath>
namespace attn_body {
using bf16=__hip_bfloat16;
using bf16x8=__attribute__((ext_vector_type(8)))short;
using s16x4=__attribute__((ext_vector_type(4)))short;
using f32x16=__attribute__((ext_vector_type(16)))float;
using u32x4=__attribute__((ext_vector_type(4)))unsigned;
constexpr int BATCH=4,NHEAD=4,SEQ=8192,D=64,DM=NHEAD*D;
constexpr int NW=8,QBLK=32,QB=QBLK*NW,KVBLK=64,NQB=SEQ/QB;
constexpr int ATTN_PITCH=DM, ATTN_UNIT_ROWS=QB;
__device__ __forceinline__ int crow(int r,int hi){return (r&3)+8*(r>>2)+4*hi;}
#define SBAR() __builtin_amdgcn_sched_barrier(0)
__device__ __forceinline__ void cmask(f32x16&p0,f32x16&p1,int jb,int qrel,int hi){
  const float NEG=-INFINITY; int kb=64*jb+4*hi;
  #pragma unroll
  for(int r=0;r<16;++r){int kv=kb+(r&3)+8*(r>>2); if(kv>qrel)p0[r]=NEG; if(kv+32>qrel)p1[r]=NEG;}
}

constexpr int NSLOT=3, SLOTB=8192;
constexpr int LDS_K=0, LDS_V=NSLOT*SLOTB, LDS_WS=2*NSLOT*SLOTB, LDS_OST=LDS_WS+NW*64*4, LDS_F=LDS_OST+NW*4096, LDS_BYTES=LDS_F+SEQ*4;
constexpr float C2=0.125f*1.4426950408889634f;
__device__ __forceinline__ void glds16(const void*gsrc,unsigned lds_dst){unsigned keep;
  asm volatile("s_mov_b32 %0, m0\n\ts_mov_b32 m0, %2\n\ts_nop 0\n\tglobal_load_lds_dwordx4 %1, off\n\ts_mov_b32 m0, %0":"=&s"(keep):"v"(gsrc),"s"(lds_dst):"memory");}
__device__ __forceinline__ float max3f(float a,float b,float c){float r;asm("v_max3_f32 %0, %1, %2, %3":"=v"(r):"v"(a),"v"(b),"v"(c));return r;}
__device__ __forceinline__ float max2f(float a,float b){float r;asm("v_max_f32_e32 %0, %1, %2":"=v"(r):"v"(a),"v"(b));return r;}
__device__ __forceinline__ float fadd_s(float a,float b){float r;asm("v_add_f32_e32 %0, %1, %2":"=v"(r):"v"(a),"v"(b));return r;}
__device__ __forceinline__ float fsub_s(float a,float b){float r;asm("v_sub_f32_e32 %0, %1, %2":"=v"(r):"v"(a),"v"(b));return r;}
typedef float f32x2_t __attribute__((ext_vector_type(2))); typedef __bf16 bf16x2_t __attribute__((ext_vector_type(2)));
__device__ __forceinline__ unsigned cvtpk_s(float lo,float hi){f32x2_t v={lo,hi};bf16x2_t b=__builtin_convertvector(v,bf16x2_t);return __builtin_bit_cast(unsigned,b);}
#define WAIT_BAR(N) asm volatile("s_waitcnt vmcnt(" #N ") lgkmcnt(0)\n\ts_barrier":::"memory")

__device__ __forceinline__ void qkt(f32x16&p0,f32x16&p1,const char*Kslot,const bf16x8*qr,const f32x16&negm,int r32,int hi){
  const char*kb=Kslot+hi*1024+r32*16;
  #pragma unroll
  for(int d0=0;d0<4;++d0){
    const bf16x8 b0=*reinterpret_cast<const bf16x8*>(kb+d0*2048);
    const bf16x8 b1=*reinterpret_cast<const bf16x8*>(kb+d0*2048+512);
    if(d0==0){p0=__builtin_amdgcn_mfma_f32_32x32x16_bf16(b0,qr[0],negm,0,0,0);p1=__builtin_amdgcn_mfma_f32_32x32x16_bf16(b1,qr[0],negm,0,0,0);}
    else{p0=__builtin_amdgcn_mfma_f32_32x32x16_bf16(b0,qr[d0],p0,0,0,0);p1=__builtin_amdgcn_mfma_f32_32x32x16_bf16(b1,qr[d0],p1,0,0,0);}}
}
typedef __attribute__((address_space(3))) const char* lds_cptr;
typedef short v4i16_t __attribute__((ext_vector_type(4)));
typedef float f32x4v __attribute__((ext_vector_type(4)));
__device__ __forceinline__ void kload8(bf16x8*kf,lds_cptr kp){
  kf[0]=*(const __attribute__((address_space(3))) bf16x8*)(kp);      kf[1]=*(const __attribute__((address_space(3))) bf16x8*)(kp+512);
  kf[2]=*(const __attribute__((address_space(3))) bf16x8*)(kp+2048); kf[3]=*(const __attribute__((address_space(3))) bf16x8*)(kp+2560);
  kf[4]=*(const __attribute__((address_space(3))) bf16x8*)(kp+4096); kf[5]=*(const __attribute__((address_space(3))) bf16x8*)(kp+4608);
  kf[6]=*(const __attribute__((address_space(3))) bf16x8*)(kp+6144); kf[7]=*(const __attribute__((address_space(3))) bf16x8*)(kp+6656);
}
__device__ __forceinline__ void kload2(bf16x8*kf,lds_cptr kp,int j){ kf[2*j]=*(const __attribute__((address_space(3))) bf16x8*)(kp+j*2048); kf[2*j+1]=*(const __attribute__((address_space(3))) bf16x8*)(kp+j*2048+512); }
__device__ __forceinline__ s16x4 vtr(lds_cptr p){ return __builtin_bit_cast(s16x4,__builtin_amdgcn_ds_read_tr16_b64_v4i16((__attribute__((address_space(3))) v4i16_t*)p)); }
__device__ __forceinline__ float rowmax(const f32x16&p0,const f32x16&p1){
  float a=max3f(p0[0],p0[1],p1[0]),b=max3f(p0[2],p0[3],p1[1]);a=max3f(a,p1[2],p1[3]);
  #pragma unroll
  for(int r=4;r<16;r+=4){a=max3f(a,p0[r],p0[r+1]);b=max3f(b,p0[r+2],p0[r+3]);a=max3f(a,p1[r],p1[r+1]);b=max3f(b,p1[r+2],p1[r+3]);}
  const float m=max2f(a,b);
  auto rr=__builtin_amdgcn_permlane32_swap(__float_as_uint(m),__float_as_uint(m),false,false);
  return max2f(__uint_as_float(rr[0]),__uint_as_float(rr[1]));
}
__device__ __forceinline__ void pv(f32x16*o,int vb,bf16x8 pa0,bf16x8 pa1,bf16x8 pa2,bf16x8 pa3){
  #pragma unroll
  for(int d0=0;d0<2;++d0){s16x4 lo[4],hi[4];
    #pragma unroll
    for(int ks=0;ks<4;++ks){
      asm volatile("ds_read_b64_tr_b16 %0,%1 offset:%c2":"=&v"(lo[ks]):"v"(vb),"i"(d0*4096+ks*1024):"memory");
      asm volatile("ds_read_b64_tr_b16 %0,%1 offset:%c2":"=&v"(hi[ks]):"v"(vb),"i"(d0*4096+ks*1024+512):"memory");}
    asm volatile("s_waitcnt lgkmcnt(0)":::"memory");SBAR();
    #define PK(k) (bf16x8){lo[k][0],lo[k][1],lo[k][2],lo[k][3],hi[k][0],hi[k][1],hi[k][2],hi[k][3]}
    o[d0]=__builtin_amdgcn_mfma_f32_32x32x16_bf16(pa0,PK(0),o[d0],0,0,0);
    o[d0]=__builtin_amdgcn_mfma_f32_32x32x16_bf16(pa1,PK(1),o[d0],0,0,0);
    o[d0]=__builtin_amdgcn_mfma_f32_32x32x16_bf16(pa2,PK(2),o[d0],0,0,0);
    o[d0]=__builtin_amdgcn_mfma_f32_32x32x16_bf16(pa3,PK(3),o[d0],0,0,0);
    #undef PK
  }
}

#ifndef ATTN_STORE16
#define ATTN_STORE16(p,v) (*(GAS u32x4*)(p)=(v))
#endif
template<int THRL> __device__ __forceinline__ void attn_unit(int b,int h,int qb,const bf16*Q,const bf16*__restrict__ K,const bf16*__restrict__ V,bf16*O,const float*__restrict__ Fc,float skipTH,char*shm,int tid_in){
  int tid=tid_in; asm volatile("":"+v"(tid));
  const int lane=tid&63,r32=lane&31,hi=lane>>5; const int wid=__builtin_amdgcn_readfirstlane(tid>>6);
  const long rowbase=(long)b*SEQ; const int q0=qb*QB;
  const bf16*Qw=Q+(rowbase+q0+wid*QBLK)*DM+h*D;
  const int NTF=(q0+QB)/KVBLK; int t0;
  { const GAS float*fb=(const GAS float*)(Fc+(long)(b*NHEAD+h)*SEQ); const float fq=fb[q0]; const int j0=lane,j1=lane+64;
    const bool c0=(j0<NTF-4)&&(fq-fb[64*j0+63]<-skipTH), c1=(j1<NTF-4)&&(fq-fb[(64*j1+63)&(SEQ-1)]<-skipTH);
    const unsigned long long m0=~__ballot(c0), m1=~__ballot(c1);
    const int js=m0?__builtin_ctzll(m0):64+(m1?__builtin_ctzll(m1):64);
    t0=__builtin_amdgcn_readfirstlane(js)&~1; }
  const bf16*Kh=K+(rowbase+(long)t0*KVBLK)*DM+h*D,*Vh=V+(rowbase+(long)t0*KVBLK)*DM+h*D;
  const unsigned lds0=(unsigned)(uintptr_t)shm;
  float*wsf=(float*)(shm+LDS_WS)+wid*64;
  const bf16*ksrc=Kh+(long)lane*DM+wid*8;
  const bf16*vsrc=Vh+(long)(16*(wid&3)+(lane>>2))*DM+(wid>>2)*32+(lane&3)*8;
  const unsigned kdst=lds0+LDS_K+wid*1024, vdst=lds0+LDS_V+wid*1024;
  #define DMA_K(t,slot) glds16(ksrc+(long)(t)*KVBLK*DM,(unsigned)__builtin_amdgcn_readfirstlane(kdst+(slot)))
  #define DMA_V(t,slot) glds16(vsrc+(long)(t)*KVBLK*DM,(unsigned)__builtin_amdgcn_readfirstlane(vdst+(slot)))
  const int vb0=(int)(lds0+LDS_V)+((lane>>4)&1)*32+(lane&3)*8+(4*hi+((lane&15)>>2))*64;
  const char*Kbase=shm+LDS_K; bf16x8 kf[8];
  const int NT=NTF-t0;
  const lds_cptr shm3=(lds_cptr)shm; const lds_cptr kp0=shm3+LDS_K+hi*1024+r32*16; const lds_cptr vp0=shm3+LDS_V+((lane>>4)&1)*32+(lane&3)*8+(4*hi+((lane&15)>>2))*64;
  const lds_cptr fl0=shm3+LDS_F+hi*16;
  #define FLDS(p) (*(const __attribute__((address_space(3))) f32x4v*)(p))
  #define FBIAS(P0,P1,t) do{ const lds_cptr fp_=fl0+(t)*256; f32x4v a_[4],b_[4]; \
    _Pragma("unroll") for(int g_=0;g_<4;++g_){ a_[g_]=FLDS(fp_+g_*32); b_[g_]=FLDS(fp_+128+g_*32); } \
    _Pragma("unroll") for(int g_=0;g_<4;++g_) _Pragma("unroll") for(int i_=0;i_<4;++i_){ P0[4*g_+i_]-=(a_[g_][i_]+mhat); P1[4*g_+i_]-=(b_[g_][i_]+mhat); } }while(0)
  f32x4v fba[4],fbb[4];
  #define FBLD_A(t) do{ const lds_cptr fp_=fl0+(t)*256; _Pragma("unroll") for(int g_=0;g_<4;++g_)fba[g_]=FLDS(fp_+g_*32); }while(0)
  #define FBLD_B(t) do{ const lds_cptr fp_=fl0+(t)*256+128; _Pragma("unroll") for(int g_=0;g_<4;++g_)fbb[g_]=FLDS(fp_+g_*32); }while(0)
  #define FBAPPLY(P0,P1) do{ _Pragma("unroll") for(int g_=0;g_<4;++g_) _Pragma("unroll") for(int i_=0;i_<4;++i_)P0[4*g_+i_]-=(fba[g_][i_]+mhat); \
    _Pragma("unroll") for(int g_=0;g_<4;++g_) _Pragma("unroll") for(int i_=0;i_<4;++i_)P1[4*g_+i_]-=(fbb[g_][i_]+mhat); }while(0)
  DMA_K(0,0);DMA_V(0,0);DMA_K(1,SLOTB);
  bf16x8 qr[4];
  #pragma unroll
  for(int d0=0;d0<4;++d0)qr[d0]=*(const GAS bf16x8*)(&Qw[(long)r32*DM+d0*16+hi*8]);
  {
    const GAS f32x4v*fsrc=(const GAS f32x4v*)(Fc+(long)(b*NHEAD+h)*SEQ+(long)t0*KVBLK); f32x4v*fdst=reinterpret_cast<f32x4v*>(shm+LDS_F);
    for(int i=tid;i<NT*KVBLK/4;i+=NW*64)fdst[i]=fsrc[i];
    asm volatile("s_waitcnt vmcnt(0) lgkmcnt(0)\n\ts_barrier":::"memory"); }
  float mhat=0.f,l_reg=0.f;f32x16 o[2];o[0]=f32x16{};o[1]=f32x16{};const f32x16 negm=f32x16{};
  const int qrel=wid*QBLK+r32;
  #define CMASK(P0,P1,t) do{int jb_=(t)-(NT-4); if(jb_>=0)cmask(P0,P1,jb_,qrel,hi);}while(0)
  bool resc=false;
  #define START(P0,P1) do{ const float rm=rowmax(P0,P1); resc=false; \
    { const float dl=rm; mhat=fadd_s(mhat,dl); \
      _Pragma("unroll") for(int r=0;r<16;++r){P0[r]=fsub_s(P0[r],dl);P1[r]=fsub_s(P1[r],dl);} \
      } \
    _Pragma("unroll") for(int r=0;r<16;++r)P0[r]=__builtin_amdgcn_exp2f(P0[r]); }while(0)
  #define RESC() do{ if(resc){ asm volatile("s_waitcnt lgkmcnt(0)":::"memory"); \
      _Pragma("unroll") for(int d_=0;d_<2;++d_) _Pragma("unroll") for(int r=0;r<16;++r)o[d_][r]*=wsf[crow(r,hi)]; } }while(0)
  f32x16 pA0,pA1,pB0,pB1;
  int sl_prev=0,sl_cur=0,sl_next=SLOTB;
  #define ROT() do{sl_prev=sl_cur;sl_cur=sl_next;sl_next=(sl_next==(NSLOT-1)*SLOTB)?0:sl_next+SLOTB;}while(0)
  DMA_K(2,2*SLOTB);
  WAIT_BAR(3);
  qkt(pA0,pA1,Kbase,qr,negm,r32,hi);asm volatile("s_nop 15\n\ts_nop 7":"+v"(pA0),"+v"(pA1));FBIAS(pA0,pA1,0);CMASK(pA0,pA1,0);
  START(pA0,pA1);
  _Pragma("unroll") for(int r=0;r<16;++r)pA1[r]=__builtin_amdgcn_exp2f(pA1[r]);
  WAIT_BAR(0);
  DMA_K(3,0);DMA_V(1,SLOTB);
  ROT();
  kload8(kf,kp0+sl_cur);
  WAIT_BAR(2);
  s16x4 vlo[8],vhi[8]; u32x4 pw0,pw1,pw2,pw3;
  #define PKW(P,B) cvtpk_s(P[B],P[B+1])
  #define PAF(k) __builtin_bit_cast(bf16x8,pw##k)
  #define VFR(i) (bf16x8){vlo[i][0],vlo[i][1],vlo[i][2],vlo[i][3],vhi[i][0],vhi[i][1],vhi[i][2],vhi[i][3]}
  #define PIN(x) asm volatile("":"+v"(x))
  #define MX3(a,b,c) __builtin_fmaxf(__builtin_fmaxf((a),(b)),(c))
  #define GAPA(MF,A0,A1,A2,A3,W0,W1,PW) do{ MF; sacc+=A0; sacc+=A1; sacc+=A2; sacc+=A3; PIN(sacc); W0; W1; PIN(PW); SBAR(); }while(0)
  #define EX(v) __builtin_amdgcn_exp2f(v)
  #define GAPB(MF,X,B) do{ MF; X[B]=EX(X[B]); X[B+1]=EX(X[B+1]); X[B+2]=EX(X[B+2]); X[B+3]=EX(X[B+3]); PIN(X); SBAR(); }while(0)
  #define VRD(i) do{ vlo[i]=vtr(vp_+(((i)>>2)*4096+((i)&3)*1024)); vhi[i]=vtr(vp_+(((i)>>2)*4096+((i)&3)*1024+512)); }while(0)
  #define KRD(G,j) do{ if(G){ kload2(kf,kp0+sl_next,j); SBAR(); } }while(0)
  #define STEP(C0,C1,P0,P1,t,GK,GV,GL) do{ SBAR(); \
    const lds_cptr vp_=vp0+sl_prev; \
    VRD(0); SBAR(); float sacc=(P0[0]+P0[1]); \
    GAPA(C0=__builtin_amdgcn_mfma_f32_32x32x16_bf16(kf[0],qr[0],negm,0,0,0), P0[2],P0[3],P0[4],P0[5],     pw0[0]=PKW(P0,0), pw0[1]=PKW(P0,2), pw0); \
    VRD(4); SBAR(); GAPA(C1=__builtin_amdgcn_mfma_f32_32x32x16_bf16(kf[1],qr[0],negm,0,0,0), P0[6],P0[7],P0[8],P0[9],     pw0[2]=PKW(P0,4), pw0[3]=PKW(P0,6), pw0); \
    VRD(1); SBAR(); GAPA(C0=__builtin_amdgcn_mfma_f32_32x32x16_bf16(kf[2],qr[1],C0,0,0,0),   P0[10],P0[11],P0[12],P0[13], pw1[0]=PKW(P0,8), pw1[1]=PKW(P0,10), pw1); \
    VRD(5); SBAR(); GAPA(C1=__builtin_amdgcn_mfma_f32_32x32x16_bf16(kf[3],qr[1],C1,0,0,0),   P0[14],P0[15],P1[0],P1[1],   pw1[2]=PKW(P0,12),pw1[3]=PKW(P0,14), pw1); \
    VRD(2); SBAR(); GAPA(C0=__builtin_amdgcn_mfma_f32_32x32x16_bf16(kf[4],qr[2],C0,0,0,0),   P1[2],P1[3],P1[4],P1[5],     pw2[0]=PKW(P1,0), pw2[1]=PKW(P1,2), pw2); \
    VRD(6); SBAR(); GAPA(C1=__builtin_amdgcn_mfma_f32_32x32x16_bf16(kf[5],qr[2],C1,0,0,0),   P1[6],P1[7],P1[8],P1[9],     pw2[2]=PKW(P1,4), pw2[3]=PKW(P1,6), pw2); \
    FBLD_A(t); VRD(3); SBAR(); GAPA(C0=__builtin_amdgcn_mfma_f32_32x32x16_bf16(kf[6],qr[3],C0,0,0,0),   P1[10],P1[11],P1[12],P1[13], pw3[0]=PKW(P1,8), pw3[1]=PKW(P1,10), pw3); \
    VRD(7); SBAR(); GAPA(C1=__builtin_amdgcn_mfma_f32_32x32x16_bf16(kf[7],qr[3],C1,0,0,0),   P1[14],P1[15],0.f,0.f,       pw3[2]=PKW(P1,12),pw3[3]=PKW(P1,14), pw3); \
    FBLD_B(t); l_reg+=sacc; \
    if(GK){DMA_K((t)+3,sl_cur);} if(GV){DMA_V((t)+1,sl_next);} \
    FBAPPLY(C0,C1); CMASK(C0,C1,t); \
    { float a=MX3(C0[0],C0[1],C1[0]),b=MX3(C0[2],C0[3],C1[1]); a=MX3(a,C1[2],C1[3]); \
      _Pragma("unroll") for(int r=4;r<16;r+=4){a=MX3(a,C0[r],C0[r+1]);b=MX3(b,C0[r+2],C0[r+3]);a=MX3(a,C1[r],C1[r+1]);b=MX3(b,C1[r+2],C1[r+3]);} \
      float rm=__builtin_fmaxf(a,b); { auto rr=__builtin_amdgcn_permlane32_swap(__float_as_uint(rm),__float_as_uint(rm),false,false); rm=__builtin_fmaxf(__uint_as_float(rr[0]),__uint_as_float(rr[1])); } \
      resc=false; \
      if(__builtin_expect(__any(rm>(float)THRL),0)){ const float dl=__builtin_fmaxf(rm,0.f); mhat+=dl; \
        _Pragma("unroll") for(int r=0;r<16;++r){C0[r]-=dl;C1[r]-=dl;} \
        const float f=__builtin_amdgcn_exp2f(-dl); l_reg*=f; if(hi==0)wsf[r32]=f; resc=true; } } \
    SBAR(); \
    GAPB(o[0]=__builtin_amdgcn_mfma_f32_32x32x16_bf16(PAF(0),VFR(0),o[0],0,0,0), C0,0); \
    GAPB(o[1]=__builtin_amdgcn_mfma_f32_32x32x16_bf16(PAF(0),VFR(4),o[1],0,0,0), C0,4); \
    KRD(GL,0); GAPB(o[0]=__builtin_amdgcn_mfma_f32_32x32x16_bf16(PAF(1),VFR(1),o[0],0,0,0), C0,8); \
    KRD(GL,1); GAPB(o[1]=__builtin_amdgcn_mfma_f32_32x32x16_bf16(PAF(1),VFR(5),o[1],0,0,0), C0,12); \
    KRD(GL,2); GAPB(o[0]=__builtin_amdgcn_mfma_f32_32x32x16_bf16(PAF(2),VFR(2),o[0],0,0,0), C1,0); \
    KRD(GL,3); GAPB(o[1]=__builtin_amdgcn_mfma_f32_32x32x16_bf16(PAF(2),VFR(6),o[1],0,0,0), C1,4); \
    GAPB(o[0]=__builtin_amdgcn_mfma_f32_32x32x16_bf16(PAF(3),VFR(3),o[0],0,0,0), C1,8); \
    GAPB(o[1]=__builtin_amdgcn_mfma_f32_32x32x16_bf16(PAF(3),VFR(7),o[1],0,0,0), C1,12); \
    }while(0)
  int t=1;
  #undef CMASK
  #define CMASK(P0,P1,t) do{}while(0)
  for(;t+5<NT;t+=2){
    STEP(pB0,pB1,pA0,pA1,t,true,true,true);     WAIT_BAR(2); RESC(); ROT();
    STEP(pA0,pA1,pB0,pB1,t+1,true,true,true);   WAIT_BAR(2); RESC(); ROT();
  }
  #undef CMASK
  #define CMASK(P0,P1,t) do{int jb_=(t)-(NT-4); if(jb_>=0)cmask(P0,P1,jb_,qrel,hi);}while(0)
  #define ENDW(tt) do{ if((tt)+3<NT){WAIT_BAR(2);} else if((tt)+2<NT){WAIT_BAR(1);} else {WAIT_BAR(0);} }while(0)
  for(;t+1<NT;t+=2){
    STEP(pB0,pB1,pA0,pA1,t,(t+3<NT),(t+1<NT),(t+1<NT));       ENDW(t);   RESC(); ROT();
    STEP(pA0,pA1,pB0,pB1,t+1,(t+4<NT),(t+2<NT),(t+2<NT));     ENDW(t+1); RESC(); ROT();
  }
  STEP(pB0,pB1,pA0,pA1,NT-1,false,false,false); RESC();
  { float sacc=pB0[0]+pB0[1]; _Pragma("unroll") for(int r=2;r<16;++r)sacc+=pB0[r]; _Pragma("unroll") for(int r=0;r<16;++r)sacc+=pB1[r]; l_reg+=sacc;
    pw0=(u32x4){PKW(pB0,0),PKW(pB0,2),PKW(pB0,4),PKW(pB0,6)};pw1=(u32x4){PKW(pB0,8),PKW(pB0,10),PKW(pB0,12),PKW(pB0,14)};pw2=(u32x4){PKW(pB1,0),PKW(pB1,2),PKW(pB1,4),PKW(pB1,6)};pw3=(u32x4){PKW(pB1,8),PKW(pB1,10),PKW(pB1,12),PKW(pB1,14)};
    SBAR(); pv(o,vb0+sl_cur,PAF(0),PAF(1),PAF(2),PAF(3)); }
  #undef PKW
  #undef PAF
  #undef VFR
  #undef PIN
  #undef MX3
  #undef GAPA
  #undef GAPB
  #undef EX
  #undef VRD
  #undef KRD
  #undef STEP
  #undef ENDW
  {auto rr=__builtin_amdgcn_permlane32_swap(__float_as_uint(l_reg),__float_as_uint(l_reg),false,false);l_reg=__uint_as_float(rr[0])+__uint_as_float(rr[1]);}
  if(hi==0)wsf[32+r32]=l_reg;asm volatile("s_waitcnt lgkmcnt(0)":::"memory");
  float rli[16];
  #pragma unroll
  for(int r=0;r<16;++r)rli[r]=__builtin_amdgcn_rcpf(wsf[32+crow(r,hi)]);
  bf16*Ow=O+(rowbase+q0+wid*QBLK)*DM+h*D;
  { bf16*stg=(bf16*)(shm+LDS_OST)+wid*2048;
    #pragma unroll
    for(int r=0;r<16;++r){const int orow=crow(r,hi);
      #pragma unroll
      for(int d0=0;d0<2;++d0)stg[orow*64+d0*32+r32]=__float2bfloat16(o[d0][r]*rli[r]);}
    asm volatile("s_waitcnt lgkmcnt(0)":::"memory");
    #pragma unroll
    for(int i=0;i<4;++i){const int row=i*8+(lane>>3),ch=lane&7; const u32x4 v=*(const u32x4*)(stg+row*64+ch*8); ATTN_STORE16(Ow+(long)row*DM+ch*8,v);} }
  asm volatile("s_waitcnt lgkmcnt(0)\n\ts_barrier":::"memory");
  #undef DMA_K
  #undef DMA_V
  #undef CMASK
  #undef START
  #undef RESC
  #undef ROT
  #undef FBIAS
  #undef FLDS
  #undef FBLD_A
  #undef FBLD_B
  #undef FBAPPLY
}
constexpr int ATTN_LDS_BYTES=LDS_BYTES;
struct AttnTensors { const bf16* Q; const bf16* K; const bf16* V; bf16* O; const float* Fc; float skipTH; };
struct AttnUnit { int bh; int qb; };
struct StaticOrder {
  int vcu,nv;
  __device__ __forceinline__ explicit StaticOrder(int grid,int block):vcu((grid%8==0)?(block%8)*(grid/8)+block/8:block),nv(grid){}
  __device__ __forceinline__ bool next(int i,AttnUnit&u)const{ const int pairu=vcu+(i>>1)*nv; if(pairu>=256)return false; const int s=pairu&15; u.bh=pairu>>4; u.qb=(i&1)?31-s:s; return true; }
  __device__ __forceinline__ void a_ready(const AttnUnit&)const{}
  __device__ __forceinline__ void done(const AttnUnit&)const{}
};
template<class Sched,int THRL=48> __device__ __forceinline__ void attn_phase(char*lds,const AttnTensors&T,const Sched&S,int tid){
  AttnUnit u;
  for(int i=0;S.next(i,u);++i){ S.a_ready(u); attn_unit<THRL>(u.bh/NHEAD,u.bh%NHEAD,u.qb,T.Q,T.K,T.V,T.O,T.Fc,T.skipTH,lds,tid); S.done(u); }
}
#undef SBAR
#undef WAIT_BAR
}
namespace cg = cooperative_groups;
using pg8::bf16_t; using pg8::f32x4; using pg8::u32x4; using pg8::bf16x8;
typedef float f32x16 __attribute__((ext_vector_type(16)));
typedef short s16x4 __attribute__((ext_vector_type(4)));
#define LAS __attribute__((address_space(3)))

struct Params { const float* in[28]; float* out; unsigned char* ws; };
typedef const __attribute__((address_space(4))) Params* PP;

__device__ __forceinline__ float wave_sum(float v) {
#pragma unroll
    for (int o = 1; o < 64; o <<= 1) v += __shfl_xor(v, o);
    return v;
}
__device__ __forceinline__ unsigned f2bf(float f) { unsigned u = __float_as_uint(f); return (u + 0x7fffu + ((u >> 16) & 1u)) >> 16; }
__device__ __forceinline__ unsigned pk2(float lo, float hi) { return f2bf(lo) | (f2bf(hi) << 16); }
__device__ __forceinline__ float bflo(unsigned u) { return __uint_as_float(u << 16); }
__device__ __forceinline__ float bfhi(unsigned u) { return __uint_as_float(u & 0xffff0000u); }

__device__ __forceinline__ void wconv_item(const float* W, int ldw, int scl  , const float* g, bf16_t* WT, int K, int dr0, int k0, float* scr, int lane) {
    float wv[32];
#pragma unroll
    for (int i = 0; i < 32; ++i) { const int kk = 2 * i + (lane >> 5); wv[i] = W[(size_t)(k0 + kk) * ldw + scl]; }
    if (g) {
#pragma unroll
        for (int i = 0; i < 32; ++i) wv[i] *= g[k0 + 2 * i + (lane >> 5)];
    }
#pragma unroll
    for (int i = 0; i < 32; ++i) scr[(2 * i + (lane >> 5)) * 33 + (lane & 31)] = wv[i];
    asm volatile("s_waitcnt lgkmcnt(0)" ::: "memory");
    const int c = lane & 7;
#pragma unroll
    for (int j = 0; j < 4; ++j) { const int n = (lane >> 3) + 8 * j; const float* s = scr + (8 * c) * 33 + n;
        u32x4 o; o.x = pk2(s[0 * 33], s[1 * 33]); o.y = pk2(s[2 * 33], s[3 * 33]); o.z = pk2(s[4 * 33], s[5 * 33]); o.w = pk2(s[6 * 33], s[7 * 33]);
        *(u32x4*)(WT + (size_t)(dr0 + n) * K + k0 + 8 * c) = o; }
    asm volatile("s_waitcnt lgkmcnt(0)" ::: "memory");
}
__device__ __forceinline__ int win_src_col(int db, int j) {
    const int pn = db >> 3, bj = (db >> 2) & 1, w = db & 3;
    if (pn < 2) return (bj ? 256 : 0) + 128 * pn + 32 * w + j;
    if (pn < 4) return (bj ? 1024 : 768) + 128 * (pn - 2) + 32 * w + j;
    if (pn == 4) return 512 + 128 * bj + 32 * w + j;
    if (pn == 5) return 1280 + 64 * w + 32 * bj + j;
    if (pn == 6) return (w < 2 ? 1536 + 64 * w : 1664 + 64 * (w - 2)) + 32 * bj + j;
    if (pn == 7) return 1792 + 64 * w + 32 * bj + j;
    if (pn == 8) return 2048 + 64 * w + 32 * bj + j;
    if (pn == 9) return 2304 + 64 * w + 32 * bj + j;
    const int fq = j >> 3, n = (j >> 2) & 1, i = j & 3;
    return 2564 + (2 * bj + n) * 1024 + 64 * (pn - 10) + 16 * w + 4 * fq + i;
}
__device__ __forceinline__ void wprep_item(PP pp, int l, int it, unsigned char* dstbase, float* scr, int lane) {
    bf16_t* wb = (bf16_t*)dstbase;
    constexpr int I0 = 176 * 16, I1 = 32 * 44, I2 = 208 * 16, I3 = 128 * 4, I4 = 32 * 16;
    int r = it;
        if (r < I0 || (r >= I0 + I1 + I2 + I3 + I4 && r < I0 + I1 + I2 + I3 + I4 + I0)) {
            const bool second = r >= I0; if (second) r -= I0 + I1 + I2 + I3 + I4;
            const int db = r % 176, kb = r / 176, pn = db >> 3, bj = (db >> 2) & 1, w = db & 3;
            const float* src = ((const float*)(GAS const float*)pp->in[second ? (bj ? 26 : 25) : (bj ? 4 : 3)]) + (size_t)l * D * DFF;
            const float* g = ((const float*)(GAS const float*)pp->in[second ? 24 : 2]) + l * D;
            wconv_item(src, DFF, 128 * pn + 32 * w + (lane & 31), g, (bf16_t*)((unsigned char*)wb + (second ? W_2GU : W_1GU)), D, db * 32, kb * 64, scr, lane);
            return;
        }
        r -= I0;
        if (r < I1 || r >= I1 + I2 + I3 + I4 + I0) {
            const bool second = r >= I1; if (second) r -= I1 + I2 + I3 + I4 + I0;
            const int db = r % 32, kb = r / 32;
            wconv_item(((const float*)(GAS const float*)pp->in[second ? 27 : 5]) + (size_t)l * DFF * D, D, 32 * db + (lane & 31), nullptr, (bf16_t*)((unsigned char*)wb + (second ? W_2D : W_1D)), DFF, db * 32, kb * 64, scr, lane);
            return;
        }
        r -= I1;
        if (r < I2) { const int db = r % 208, kb = r / 208;
            wconv_item(((const float*)(GAS const float*)pp->in[7]) + (size_t)l * D * INC, INC, win_src_col(db, lane & 31), ((const float*)(GAS const float*)pp->in[6]) + l * D, (bf16_t*)((unsigned char*)wb + W_IN), D, db * 32, kb * 64, scr, lane); return; }
        r -= I2;
        if (r < I3) { const int db = r % 128, kb = r / 128, i = db >> 5;
            const float* src = ((const float*)(GAS const float*)pp->in[i == 0 ? 13 : i == 1 ? 15 : i == 2 ? 19 : 22]) + (size_t)l * 256 * D;
            wconv_item(src, D, 32 * (db & 31) + (lane & 31), nullptr, (bf16_t*)((unsigned char*)wb + W_BR), 256, db * 32, kb * 64, scr, lane); return; }
        r -= I3;
        { const int db = r % 32, kb = r / 32;
            wconv_item(((const float*)(GAS const float*)pp->in[23]) + (size_t)l * D * D, D, 32 * db + (lane & 31), nullptr, (bf16_t*)((unsigned char*)wb + W_OUT), D, db * 32, kb * 64, scr, lane); }
}
constexpr int WPREP_NIT = 2 * (176 * 16) + 2 * (32 * 44) + 208 * 16 + 128 * 4 + 32 * 16, WPREP_W2D_FIRST = WPREP_NIT - 32 * 44;
__device__ __forceinline__ void wprep_layer(PP pp, int l, unsigned char* lds, int gw, int ngw, int wave, int lane) {
    float* scr = (float*)(lds + wave * 16384);
    for (int it = gw; it < WPREP_NIT; it += ngw) wprep_item(pp, l, it, pp->ws + WS_W, scr, lane);
}
__device__ __forceinline__ void prep_x(const float* x, bf16_t* xb, float* ss, int gw, int ngw, int lane) {
    for (int m0 = gw; m0 < M; m0 += 4 * ngw) {
        f32x4 v[4][4];
#pragma unroll
        for (int r = 0; r < 4; ++r) { const int m = m0 + r * ngw < M ? m0 + r * ngw : M - 1; const GAS f32x4* xr = (const GAS f32x4*)(x + (size_t)m * D) + lane;
#pragma unroll
            for (int j = 0; j < 4; ++j) v[r][j] = xr[64 * j]; }
#pragma unroll
        for (int r = 0; r < 4; ++r) {
            const int m = m0 + r * ngw; if (m >= M) break;
            float s = 0.f;
#pragma unroll
            for (int j = 0; j < 4; ++j) s += (v[r][j][0] * v[r][j][0] + v[r][j][1] * v[r][j][1]) + (v[r][j][2] * v[r][j][2] + v[r][j][3] * v[r][j][3]);
            s = wave_sum(s);
            GAS unsigned long long* o8 = (GAS unsigned long long*)(xb + (size_t)m * D) + lane;
#pragma unroll
            for (int j = 0; j < 4; ++j) o8[64 * j] = (unsigned long long)pk2(v[r][j][0], v[r][j][1]) | ((unsigned long long)pk2(v[r][j][2], v[r][j][3]) << 32);
            if (lane < 16) *(GAS float*)(ss + (size_t)m * 16 + lane) = lane == 0 ? s : 0.f;
        }
    }
}
__device__ __forceinline__ void forget_rows(PP pp, int l, const bf16_t* x, const float* ss, float* lf, unsigned char* lds, int gw, int ngw, int tid, int lane) {
    float* wf = (float*)lds;
    const float* win = ((const float*)(GAS const float*)pp->in[7]) + (size_t)l * D * INC + 2560; const float* g = ((const float*)(GAS const float*)pp->in[6]) + l * D;
    for (int k = tid; k < D; k += NTHR) { const float gk = g[k]; const float* w = win + (size_t)k * INC;
#pragma unroll
        for (int h = 0; h < 4; ++h) wf[h * D + k] = w[h] * gk; }
    __syncthreads();
    const float* bf = ((const float*)(GAS const float*)pp->in[8]) + l * 4;
    for (int m0 = gw; m0 < M; m0 += 4 * ngw) {
        u32x4 xv[4][2]; float rsr[4];
#pragma unroll
        for (int r = 0; r < 4; ++r) { const int m = m0 + r * ngw < M ? m0 + r * ngw : M - 1; const GAS u32x4* xr = (const GAS u32x4*)(x + (size_t)m * D) + lane; xv[r][0] = xr[0]; xv[r][1] = xr[64]; rsr[r] = pg8::rs_row(ss, m); }
#pragma unroll
        for (int r = 0; r < 4; ++r) {
            const int m = m0 + r * ngw; f32x4 a = (f32x4){0.f, 0.f, 0.f, 0.f};
#pragma unroll
            for (int j = 0; j < 2; ++j) { const int k0 = 512 * j + 8 * lane; const f32x4 v0 = pg8::bf_lo4(xv[r][j].x, xv[r][j].y), v1 = pg8::bf_lo4(xv[r][j].z, xv[r][j].w);
#pragma unroll
                for (int h = 0; h < 4; ++h) { const f32x4 w0 = *(const f32x4*)(wf + h * D + k0), w1 = *(const f32x4*)(wf + h * D + k0 + 4);
                    a[h] += ((w0[0] * v0[0] + w0[1] * v0[1]) + (w0[2] * v0[2] + w0[3] * v0[3])) + ((w1[0] * v1[0] + w1[1] * v1[1]) + (w1[2] * v1[2] + w1[3] * v1[3])); } }
#pragma unroll
            for (int h = 0; h < 4; ++h) { const float f = wave_sum(a[h]) * rsr[r] + bf[h]; const float v = fminf(f, 0.f) - __logf(1.0f + __expf(-fabsf(f))); if (lane == h && m < M) *(GAS float*)(lf + (size_t)m * 4 + h) = v; }
        }
    }
    __syncthreads();
}
__device__ __forceinline__ void forget_scan(const float* lf, float* fc, unsigned char* lds, int seq, int wave, int lane) {
    const int b = seq >> 2, h = seq & 3; float* wtot = (float*)lds;
    const int t0 = 1024 * wave + 16 * lane; float v[16]; float s = 0.f;
#pragma unroll
    for (int i = 0; i < 16; ++i) { v[i] = *(const GAS float*)(lf + ((size_t)b * SEQ + t0 + i) * 4 + h); s += v[i]; }
    float inc = s;
#pragma unroll
    for (int o = 1; o < 64; o <<= 1) { const float t = __shfl_up(inc, o); if (lane >= o) inc += t; }
    if (lane == 63) wtot[wave] = inc;
    __syncthreads();
    float run = inc - s;
    for (int w = 0; w < wave; ++w) run += wtot[w];
#pragma unroll
    for (int i = 0; i < 16; ++i) { run += v[i]; *(GAS float*)(fc + (size_t)seq * SEQ + t0 + i) = run * LOG2E; }
    __syncthreads();
}
__device__ __forceinline__ void conformer_unit(int unit, const bf16_t* U, const float* dw, const float* dwb, const float* lng, const float* lnb, bf16_t* out, unsigned char* lds, int tid, int wave, int lane) {
    const int r0 = unit * 64, tl0 = r0 % SEQ;
    unsigned short* ub = (unsigned short*)lds;
    float* yb = (float*)(lds + 49152);
    { u32x4 v[6];
#pragma unroll
        for (int i = 0; i < 6; ++i) { const int c = tid + i * NTHR, rr = c >> 5, ch = c & 31; v[i] = (u32x4){0u, 0u, 0u, 0u};
            if (c < 94 * 32 && tl0 - 30 + rr >= 0) v[i] = *(const GAS u32x4*)(U + (size_t)(r0 - 30 + rr) * 256 + ch * 8); }
#pragma unroll
        for (int i = 0; i < 6; ++i) { const int c = tid + i * NTHR, rr = c >> 5, ch = c & 31; if (c < 94 * 32) *(u32x4*)(ub + rr * 256 + ch * 8) = v[i]; } }
    __syncthreads();
    {
        typedef float f32x2c __attribute__((ext_vector_type(2)));
        const int cp = tid & 127, tg = tid >> 7; f32x2c w2[31], a2[16];
#pragma unroll
        for (int k = 0; k < 31; ++k) w2[k] = *(const GAS f32x2c*)(dw + k * 256 + 2 * cp);
        const f32x2c b2 = *(const GAS f32x2c*)(dwb + 2 * cp);
#pragma unroll
        for (int j = 0; j < 16; ++j) a2[j] = b2;
#pragma unroll
        for (int r = 0; r < 46; ++r) {
            const unsigned pv = *(const unsigned*)(ub + (tg * 16 + r) * 256 + 2 * cp); const f32x2c u2 = (f32x2c){bflo(pv), bfhi(pv)};
#pragma unroll
            for (int j = (r > 30 ? r - 30 : 0); j <= (r < 15 ? r : 15); ++j) a2[j] += w2[r - j] * u2;
        }
#pragma unroll
        for (int j = 0; j < 16; ++j) *(f32x2c*)(yb + (tg * 16 + j) * 256 + 2 * cp) = a2[j]; }
    __syncthreads();
    { const f32x4 g = *(const GAS f32x4*)(lng + 4 * lane), bb = *(const GAS f32x4*)(lnb + 4 * lane);
#pragma unroll 1
        for (int j = wave; j < 64; j += NWAVES) {
            const f32x4 v = *(const f32x4*)(yb + j * 256 + 4 * lane);
            const float mean = wave_sum((v[0] + v[1]) + (v[2] + v[3])) * (1.0f / 256.0f);
            const f32x4 d = v - mean;
            const float var = wave_sum((d[0] * d[0] + d[1] * d[1]) + (d[2] * d[2] + d[3] * d[3])) * (1.0f / 256.0f);
            const float rstd = rsqrtf(var + EPS);
            f32x4 o = d * rstd * g + bb;
#pragma unroll
            for (int i = 0; i < 4; ++i) o[i] = pg8::fsilu(o[i]);
            *(GAS unsigned long long*)(out + (size_t)(r0 + j) * 256 + 4 * lane) = (unsigned long long)pk2(o[0], o[1]) | ((unsigned long long)pk2(o[2], o[3]) << 32);
        } }
    __syncthreads();
}
__device__ __forceinline__ void shortconv_all(const bf16_t* __restrict__ SCX, const bf16_t* __restrict__ SB, const float* __restrict__ w, bf16_t* __restrict__ out, int gtid, int ngt) {
    for (int it = gtid; it < (M / 8) * 32; it += ngt) {
        const int ch = it & 31, r0 = (it >> 5) * 8; const bool head = (r0 % SEQ) == 0;
        u32x4 xs[10], sb[8];
#pragma unroll
        for (int r = 0; r < 10; ++r) { const int rr = (r < 2 && head) ? r0 : r0 - 2 + r; xs[r] = *(const GAS u32x4*)(SCX + (size_t)rr * 256 + 8 * ch); }
#pragma unroll
        for (int r = 0; r < 8; ++r) sb[r] = *(const GAS u32x4*)(SB + (size_t)(r0 + r) * 256 + 8 * ch);
        if (head) { xs[0] = (u32x4){0u, 0u, 0u, 0u}; xs[1] = (u32x4){0u, 0u, 0u, 0u}; }
        f32x4 wv[3][2];
#pragma unroll
        for (int k = 0; k < 3; ++k)
#pragma unroll
            for (int hh = 0; hh < 2; ++hh) wv[k][hh] = *(const GAS f32x4*)(w + k * 256 + 8 * ch + 4 * hh);
#pragma unroll
        for (int r = 0; r < 8; ++r) {
            f32x4 o[2];
#pragma unroll
            for (int hh = 0; hh < 2; ++hh) {
                const f32x4 a0 = hh ? pg8::bf_lo4(xs[r].z, xs[r].w) : pg8::bf_lo4(xs[r].x, xs[r].y), a1 = hh ? pg8::bf_lo4(xs[r + 1].z, xs[r + 1].w) : pg8::bf_lo4(xs[r + 1].x, xs[r + 1].y),
                            a2 = hh ? pg8::bf_lo4(xs[r + 2].z, xs[r + 2].w) : pg8::bf_lo4(xs[r + 2].x, xs[r + 2].y);
                const f32x4 sv = hh ? pg8::bf_lo4(sb[r].z, sb[r].w) : pg8::bf_lo4(sb[r].x, sb[r].y);
                o[hh] = sv * (wv[0][hh] * a0 + wv[1][hh] * a1 + wv[2][hh] * a2);
            }
            pg8::store8(out + (size_t)(r0 + r) * 256 + 8 * ch, o[0], o[1]);
        }
    }
}
__device__ __forceinline__ int crow(int r, int hi) { return (r & 3) + 8 * (r >> 2) + 4 * hi; }
#define MFMA32(a, b, c) __builtin_amdgcn_mfma_f32_32x32x16_bf16((a), (b), (c), 0, 0, 0)
template <int MODE>
__device__ __forceinline__ void attn_wave_unit(const bf16_t* Q, int qpitch, const bf16_t* K, int kpitch, const bf16_t* Vt, bf16_t* O, int q0,
                                               const float* Fk, const float* btab, float sink2, float* wsf, int lane) {
    const int r32 = lane & 31, hi = lane >> 5;
    bf16x8 qf[4];
#pragma unroll
    for (int d0 = 0; d0 < 4; ++d0) qf[d0] = *(const GAS bf16x8*)(Q + (size_t)(q0 + r32) * qpitch + 16 * d0 + 8 * hi);
    f32x16 o0, o1;
#pragma unroll
    for (int r = 0; r < 16; ++r) { o0[r] = 0.f; o1[r] = 0.f; }
    float m_run = MODE == 0 ? sink2 : -1e30f, l_run = (MODE == 0 && hi == 0) ? 1.f : 0.f;
    const int ks_begin = MODE == 0 ? (q0 >= 128 ? q0 - 128 : 0) : 0, ks_end = q0;
    const int qq = q0 + r32;
    bf16x8 kf[4];
#pragma unroll
    for (int d0 = 0; d0 < 4; ++d0) kf[d0] = *(const GAS bf16x8*)(K + (size_t)(ks_begin + r32) * kpitch + 16 * d0 + 8 * hi);
    for (int ks = ks_begin; ks <= ks_end; ks += 32) {
        s16x4 vlo[2][2], vhh[2][2]; bf16x8 kn[4];
#pragma unroll
        for (int st = 0; st < 2; ++st)
#pragma unroll
            for (int db = 0; db < 2; ++db) { const bf16_t* vp = Vt + (size_t)(r32 + 32 * db) * SEQ + ks + 16 * st + 4 * hi; vlo[st][db] = *(const GAS s16x4*)vp; vhh[st][db] = *(const GAS s16x4*)(vp + 8); }
        { const int kq = ks + 32 <= ks_end ? ks + 32 : ks;
#pragma unroll
            for (int d0 = 0; d0 < 4; ++d0) kn[d0] = *(const GAS bf16x8*)(K + (size_t)(kq + r32) * kpitch + 16 * d0 + 8 * hi); }
        f32x16 s;
#pragma unroll
        for (int r = 0; r < 16; ++r) s[r] = 0.f;
#pragma unroll
        for (int d0 = 0; d0 < 4; ++d0) { s = MFMA32(kf[d0], qf[d0], s); kf[d0] = kn[d0]; }
        float bmax = -1e30f;
#pragma unroll
        for (int g = 0; g < 4; ++g) {
            f32x4 fk4 = (f32x4){0.f, 0.f, 0.f, 0.f};
            if (MODE == 1) fk4 = *(const GAS f32x4*)(Fk + ks + 8 * g + 4 * hi);
#pragma unroll
            for (int i = 0; i < 4; ++i) { const int r = 4 * g + i, key = ks + 8 * g + 4 * hi + i; float v;
                if (MODE == 1) v = key <= qq ? s[r] - fk4[i] : -1e30f;
                else { v = s[r] + btab[qq - key + 32]; }
                s[r] = v; bmax = fmaxf(bmax, v); }
        }
        bmax = fmaxf(bmax, __shfl_xor(bmax, 32));
        const float m_new = fmaxf(m_run, bmax), alpha = __builtin_amdgcn_exp2f(m_run - m_new); m_run = m_new;
        float lsum = 0.f;
#pragma unroll
        for (int r = 0; r < 16; ++r) { s[r] = __builtin_amdgcn_exp2f(s[r] - m_new); lsum += s[r]; }
        l_run = l_run * alpha + lsum;
        if (hi == 0) wsf[r32] = alpha;
        asm volatile("s_waitcnt lgkmcnt(0)" ::: "memory");
#pragma unroll
        for (int g = 0; g < 4; ++g) { const f32x4 a4 = *(const f32x4*)(wsf + 8 * g + 4 * hi);
#pragma unroll
            for (int i = 0; i < 4; ++i) { o0[4 * g + i] *= a4[i]; o1[4 * g + i] *= a4[i]; } }
        asm volatile("s_waitcnt lgkmcnt(0)" ::: "memory");
#pragma unroll
        for (int st = 0; st < 2; ++st) {
            u32x4 pw; pw.x = pg8::cvt_pk_bf16(s[8 * st + 0], s[8 * st + 1]); pw.y = pg8::cvt_pk_bf16(s[8 * st + 2], s[8 * st + 3]); pw.z = pg8::cvt_pk_bf16(s[8 * st + 4], s[8 * st + 5]); pw.w = pg8::cvt_pk_bf16(s[8 * st + 6], s[8 * st + 7]);
            const bf16x8 pa = __builtin_bit_cast(bf16x8, pw);
#pragma unroll
            for (int db = 0; db < 2; ++db) {
                const bf16x8 vb = __builtin_shufflevector(vlo[st][db], vhh[st][db], 0, 1, 2, 3, 4, 5, 6, 7);
                if (db == 0) o0 = MFMA32(pa, vb, o0); else o1 = MFMA32(pa, vb, o1);
            }
        }
    }
    l_run += __shfl_xor(l_run, 32);
    if (hi == 0) wsf[r32] = 1.0f / l_run;
    asm volatile("s_waitcnt lgkmcnt(0)" ::: "memory");
#pragma unroll
    for (int g = 0; g < 4; ++g) { const f32x4 a4 = *(const f32x4*)(wsf + 8 * g + 4 * hi);
#pragma unroll
        for (int i = 0; i < 4; ++i) { const int r = 4 * g + i; bf16_t* op = O + (size_t)(q0 + crow(r, hi)) * 256 + r32;
            *(GAS bf16_t*)op = (bf16_t)f2bf(o0[r] * a4[i]); *(GAS bf16_t*)(op + 32) = (bf16_t)f2bf(o1[r] * a4[i]); } }
    asm volatile("s_waitcnt lgkmcnt(0)" ::: "memory");
}

#define XB_TMO      128
#define XB_XCNT(j)  (256  + 64 * (j))
#define XB_XSUB(j)  (1280 + 64 * (j))
#define XB_XGEN(j)  (2304 + 64 * (j))
#define XB_TOP      3328
#define XB_TOPGEN   3392
#define XCD_BAR_WORDS 3456
#define XB_SPIN_CAP (1u << 18)

__device__ __forceinline__ unsigned xb_ld(unsigned* p)              { return __hip_atomic_load(p, __ATOMIC_RELAXED, __HIP_MEMORY_SCOPE_AGENT); }
__device__ __forceinline__ unsigned xb_add(unsigned* p, unsigned v) { return __hip_atomic_fetch_add(p, v, __ATOMIC_RELAXED, __HIP_MEMORY_SCOPE_AGENT); }
__device__ __forceinline__ unsigned xb_xcc_id() { return (unsigned)__builtin_amdgcn_s_getreg((3 << 11) | 20) & 0xFu; }
#define XB_SPIN(cond, bar) do { unsigned _sp = 0; while (cond) { __builtin_amdgcn_s_sleep(1); \
    if ((++_sp & 255u) == 0u) { if (xb_ld(&(bar)[XB_TMO])) break; if (_sp > XB_SPIN_CAP) { atomicAdd(&(bar)[XB_TMO], 1u); break; } } } } while (0)

struct XcdBarrier {
    unsigned* bar; unsigned x; bool lead;
    volatile LAS unsigned* st;
};

__device__ __forceinline__ XcdBarrier xcd_barrier_post(unsigned* bar, volatile LAS unsigned* st) {
    XcdBarrier b; b.bar = bar; b.x = xb_xcc_id(); b.st = st;
    if (threadIdx.x == 0) (void)xb_add(&bar[XB_XCNT(b.x)], 1u);
    return b;
}
__device__ __forceinline__ void xcd_barrier_complete(unsigned* bar, unsigned x, unsigned& nloc, unsigned& nx) {
    const unsigned G = gridDim.x * gridDim.y * gridDim.z;
    unsigned sum, cnt, mine, sp = 0u;
    for (;;) {
        sum = 0u; cnt = 0u; mine = 0u;
#pragma unroll
        for (unsigned j = 0; j < 16; ++j) { const unsigned c = xb_ld(&bar[XB_XCNT(j)]); sum += c; cnt += (c > 0u) ? 1u : 0u; mine = (j == x) ? c : mine; }
        if (sum == G) break;
        __builtin_amdgcn_s_sleep(1);
        if ((++sp & 255u) == 0u) { if (xb_ld(&bar[XB_TMO])) break; if (sp > XB_SPIN_CAP) { atomicAdd(&bar[XB_TMO], 1u); break; } }
    }
    nloc = mine > 0u ? mine : 1u; nx = cnt > 0u ? cnt : 1u;
}

__device__ __forceinline__ void xcd_barrier(const XcdBarrier& b) {
    asm volatile("s_waitcnt vmcnt(0)" ::: "memory");
    __syncthreads();
    if (b.lead) {
        unsigned* bar = b.bar;
        __builtin_amdgcn_s_waitcnt(0);
        unsigned nloc = b.st[0], nx = b.st[1];
        if (nloc == 0u) { xcd_barrier_complete(bar, b.x, nloc, nx); b.st[0] = nloc; b.st[1] = nx; }
        const unsigned old = xb_add(&bar[XB_XSUB(b.x)], 1u);
        const unsigned gen = old / nloc;
        if (old + 1u == (gen + 1u) * nloc) {
            __builtin_amdgcn_fence(__ATOMIC_RELEASE, "agent");
            asm volatile("s_waitcnt vmcnt(0)" ::: "memory");
            const unsigned og = xb_add(&bar[XB_TOP], 1u);
            const unsigned tg = og / nx;
            if (og + 1u == (tg + 1u) * nx) xb_add(&bar[XB_TOPGEN], 1u);
            else XB_SPIN(xb_ld(&bar[XB_TOPGEN]) == tg, bar);
            __builtin_amdgcn_fence(__ATOMIC_ACQUIRE, "agent");
            xb_add(&bar[XB_XGEN(b.x)], 1u);
            asm volatile("s_waitcnt vmcnt(0)" ::: "memory");
        } else {
            XB_SPIN(xb_ld(&bar[XB_XGEN(b.x)]) == gen, bar);
            __builtin_amdgcn_fence(__ATOMIC_ACQUIRE, "agent");
            asm volatile("s_waitcnt vmcnt(0)" ::: "memory");
        }
    }
    __syncthreads();
}

#define GIN(k) ((const float*)(GAS const float*)pp->in[k])
#define GOUT ((float*)(GAS float*)pp->out)
#define WL_BASE (l == 0 ? w + WS_W : (unsigned char*)GOUT + 64 * MiB)
#define PH_BEGIN() PP pp = (PP)__builtin_amdgcn_kernarg_segment_ptr(); asm volatile("" : "+s"(pp)); unsigned char* w = pp->ws; asm volatile("" : "+s"(w)); \
    int lane; asm volatile("v_mbcnt_lo_u32_b32 %0, -1, 0\n\tv_mbcnt_hi_u32_b32 %0, -1, %0" : "=v"(lane)); int wave = wave0; asm volatile("" : "+s"(wave)); const int tid = wave * 64 + lane; \
    int bid = blockIdx.x; asm volatile("" : "+s"(bid)); \
    const int G = gridDim.x, gw = bid * NWAVES + wave, ngw = G * NWAVES; (void)tid; (void)gw; (void)ngw; \
    PG8_LAS unsigned char* lds3 = (PG8_LAS unsigned char*)lds; (void)lds3
__global__ void __launch_bounds__(NTHR, 2) fwd_kernel(Params p) {
    extern __shared__ __attribute__((aligned(16))) unsigned char lds[];
    const int wave0 = __builtin_amdgcn_readfirstlane((int)threadIdx.x >> 6);
    volatile LAS unsigned* MISC = (volatile LAS unsigned*)((LAS unsigned char*)lds + 131072 + 320);
    if (threadIdx.x < 32) MISC[threadIdx.x] = 0u;
    __syncthreads();
    cg::this_grid().sync();
    { PP pp0 = (PP)__builtin_amdgcn_kernarg_segment_ptr(); XcdBarrier xbar = xcd_barrier_post((unsigned*)(pp0->ws + WS_CTL) + 4096, MISC + 8); if (threadIdx.x == 0) MISC[10] = xbar.x; }
    __syncthreads();
#define GRID_SYNC() do { PP pq_ = (PP)__builtin_amdgcn_kernarg_segment_ptr(); asm volatile("" : "+s"(pq_)); int ln_; asm volatile("v_mbcnt_lo_u32_b32 %0, -1, 0\n\tv_mbcnt_hi_u32_b32 %0, -1, %0" : "=v"(ln_)); \
        int wv_ = wave0; asm volatile("" : "+s"(wv_)); volatile LAS unsigned* st_ = (volatile LAS unsigned*)((LAS unsigned char*)lds + 131072 + 320) + 8; \
        XcdBarrier xb_; xb_.bar = (unsigned*)(pq_->ws + WS_CTL) + 4096; xb_.lead = (wv_ == 0 && ln_ == 0); xb_.x = xb_.lead ? st_[2] : 0u; xb_.st = st_; xcd_barrier(xb_); } while (0)
#ifdef DIAG_FILL
    {
        PH_BEGIN();
        u32x4 pz = (u32x4){0xAAAAAAAAu, 0xAAAAAAAAu, 0xAAAAAAAAu, 0xAAAAAAAAu};
        u32x4* a = (u32x4*)(w + 2 * MiB); const size_t n = (WS_END - 2 * MiB) / 16;
        for (size_t i = (size_t)bid * NTHR + tid; i < n; i += (size_t)G * NTHR) a[i] = pz;
        u32x4* o = (u32x4*)GOUT; const size_t no = (size_t)M * D * 4 / 16;
        for (size_t i = (size_t)bid * NTHR + tid; i < no; i += (size_t)G * NTHR) o[i] = pz;
    }
    GRID_SYNC();
#endif
#ifndef SKIP_PREP
#ifdef DUP_PREP
#pragma unroll 1
    for (int rep_ = 0; rep_ < 2; ++rep_) {
#endif
    {
        PH_BEGIN();
        prep_x(GIN(0), (bf16_t*)(w + WS_XB), (float*)(w + WS_SSP), gw, ngw, lane);
        if (bid == 0) { float* cw = (float*)(w + WS_CONST); const int l = tid >> 8, r = tid & 255, which = r >> 6, i = r & 63;
            cw[tid] = GIN(which == 0 ? 16 : which == 1 ? 17 : which == 2 ? 20 : 21)[l * 64 + i]; }
        wprep_layer(pp, 0, lds, gw, ngw, wave, lane);
    }
#ifdef DUP_PREP
    GRID_SYNC(); }
#endif
#endif
    GRID_SYNC();
#ifdef DUP_BAR
#pragma unroll 1
    for (int rep_ = 0; rep_ < 20; ++rep_) { GRID_SYNC(); }
#endif
#pragma unroll 1
    for (int l = 0; l < 2; ++l) {
#pragma unroll 1
        for (int j = 0; j < 3; ++j) {
            if (j != 1) {
#ifndef SKIP_FFNUP
#ifdef DUP_FFNUP
#pragma unroll 1
                for (int rep_ = 0; rep_ < 2; ++rep_) {
#endif
                PH_BEGIN();
                pg8::Gemm g{(const bf16_t*)(w + WS_XB), (const bf16_t*)(WL_BASE + (j == 0 ? W_1GU : W_2GU)), M, 2 * DFF, D};
                pg8::StaticOrder S; S.init(M, 2 * DFF, G, bid);
                pg8::EpiSwiglu E{w, (const float*)(w + WS_SSP), (PG8_LAS const float*)(lds3 + LDS_RS)};
                pg8::gemm_phase<pg8::EpiSwiglu, pg8::StaticOrder, true, true>(lds3, g, S, E, tid);
#ifdef DUP_FFNUP
                }
#endif
#endif
            } else {
#ifndef SKIP_FROWS
#ifdef DUP_FROWS
#pragma unroll 1
                for (int rep_ = 0; rep_ < 2; ++rep_) {
#endif
                { PH_BEGIN(); forget_rows(pp, l, (const bf16_t*)(w + WS_XB), (const float*)(w + WS_SSP), (float*)(w + WS_LF), lds, gw, ngw, tid, lane); }
#ifdef DUP_FROWS
                }
#endif
#endif
#ifndef SKIP_WIN
#ifdef DUP_WIN
#pragma unroll 1
                for (int rep_ = 0; rep_ < 2; ++rep_) {
#endif
                {
                    PH_BEGIN();
                    pg8::Gemm g{(const bf16_t*)(w + WS_XB), (const bf16_t*)(WL_BASE + W_IN), M, NWIN, D};
                    pg8::StaticOrder S; S.init(M, NWIN, G, bid);
                    pg8::EpiWin E{w, (const float*)(w + WS_SSP), l, (PG8_LAS const float*)(lds3 + LDS_RS)};
                    pg8::gemm_phase<pg8::EpiWin, pg8::StaticOrder, true, true>(lds3, g, S, E, tid);
                }
#ifdef DUP_WIN
                }
#endif
#endif
                GRID_SYNC();
#ifndef SKIP_SCAN
                { PH_BEGIN(); for (int seq = bid; seq < 16; seq += G) forget_scan((const float*)(w + WS_LF), (float*)(w + WS_FC), lds, seq, wave, lane); }
#endif
#if !DYNQ
#ifndef SKIP_CONF
#ifdef DUP_CONF
#pragma unroll 1
                for (int rep_ = 0; rep_ < 2; ++rep_) {
#endif
                { PH_BEGIN(); for (int u = bid; u < M / 64; u += G)
                    conformer_unit(u, (const bf16_t*)(w + WS_R1 + R_U), GIN(9) + l * 31 * 256, GIN(10) + l * 256, GIN(11) + l * 256, GIN(12) + l * 256, (bf16_t*)GOUT  , lds, tid, wave, lane); }
#ifdef DUP_CONF
                }
#endif
#endif
#ifndef SKIP_SC
#ifdef DUP_SC
#pragma unroll 1
                for (int rep_ = 0; rep_ < 2; ++rep_) {
#endif
                { PH_BEGIN(); shortconv_all((const bf16_t*)(w + WS_R1 + R_SCX), (const bf16_t*)(w + WS_R1 + R_SB), GIN(14) + l * 3 * 256, (bf16_t*)GOUT + (size_t)M * 256  , bid * NTHR + tid, G * NTHR); }
#ifdef DUP_SC
                }
#endif
#endif
#ifndef SKIP_SWA
#ifdef DUP_SWA
#pragma unroll 1
                for (int rep_ = 0; rep_ < 2; ++rep_) {
#endif
                {
                    PH_BEGIN();
                    float* btab = (float*)lds;
                    float* wsf = (float*)(lds + 4096) + wave * 64;
                    for (int e = tid; e < 4 * 192; e += NTHR) { const int h = e / 192, dist = e % 192 - 32; float v = -1e30f;
                        if (dist >= 0 && dist < 128) { int bucket = dist;
                            if (dist >= 16) { bucket = 16 + (int)(logf((float)dist / 16.0f) / 2.0794415416798357f * 16.0f); bucket = bucket > 31 ? 31 : bucket; }
                            v = GIN(1)[bucket * 4 + h] * LOG2E; }
                        btab[e] = v; }
                    __syncthreads();
                    const bf16_t* r1 = (const bf16_t*)(w + WS_R1);
#pragma unroll 1
                    for (int u = gw; u < BATCH * 4 * (SEQ / 32); u += ngw) {
                        const int qblk = u & 255, hq = (u >> 8) & 3, b = u >> 10, kvh = hq >> 1;
                        attn_wave_unit<0>(r1 + R_AQ / 2 + (size_t)b * SEQ * 256 + hq * 64, 256, r1 + R_AK / 2 + (size_t)b * SEQ * 128 + kvh * 64, 128,
                                          r1 + R_AVT / 2 + (size_t)(b * 2 + kvh) * 64 * SEQ, (bf16_t*)GOUT + (size_t)2 * M * 256 + (size_t)b * SEQ * 256 + hq * 64, qblk * 32,
                                          nullptr, btab + hq * 192, GIN(18)[l * 4 + hq] * LOG2E, wsf, lane);
                    }
                    __syncthreads();
                }
#ifdef DUP_SWA
                }
#endif
#endif
#endif
                GRID_SYNC();
#ifndef SKIP_FOX
#ifdef DUP_FOX
#pragma unroll 1
                for (int rep_ = 0; rep_ < 2; ++rep_) {
#endif
#if FOX_ROWMAJOR_V
                {
                    PH_BEGIN();
                    static_assert(attn_body::ATTN_LDS_BYTES <= 131072 && attn_body::ATTN_PITCH == 256, "attention body geometry");
                    float skipTH;
                    { const float* cw = (const float*)(w + WS_CONST) + l * 256; float mq = fabsf(cw[128 + lane]), mk = fabsf(cw[192 + lane]);
#pragma unroll
                        for (int o = 1; o < 64; o <<= 1) { mq = fmaxf(mq, __shfl_xor(mq, o)); mk = fmaxf(mk, __shfl_xor(mk, o)); }
                        skipTH = (104.0f + 2.0f * (8.0f * mq * mk * 1.02f)) * LOG2E + 2.0f; }
#ifdef NO_SKIP
                    skipTH = 1e30f;
#endif
                    const attn_body::AttnTensors AT{(const attn_body::bf16*)(w + WS_R1 + R_FQ), (const attn_body::bf16*)(w + WS_R1 + R_FK), (const attn_body::bf16*)(w + WS_R1 + R_FV),
                                                    (attn_body::bf16*)GOUT + (size_t)3 * M * 256, (const float*)(w + WS_FC), skipTH};
                    const attn_body::StaticOrder S(G, bid);
                    attn_body::attn_phase<attn_body::StaticOrder>((char*)lds, AT, S, tid);
                    __syncthreads();
                }
#else
                {
                    PH_BEGIN();
                    float* wsf = (float*)lds + wave * 64;
                    const bf16_t* r1 = (const bf16_t*)(w + WS_R1);
#pragma unroll 1
                    for (int pu = gw; pu < 2048; pu += ngw) {
                        const int bh = pu >> 7, pr = pu & 127, b = bh >> 2, h = bh & 3;
#pragma unroll 1
                        for (int e = 0; e < 2; ++e) { const int qblk = e ? 255 - pr : pr;
                            attn_wave_unit<1>(r1 + R_FQ / 2 + (size_t)b * SEQ * 256 + h * 64, 256, r1 + R_FK / 2 + (size_t)b * SEQ * 256 + h * 64, 256,
                                              r1 + R_FV / 2 + (size_t)bh * 64 * SEQ, (bf16_t*)GOUT + (size_t)3 * M * 256 + (size_t)b * SEQ * 256 + h * 64, qblk * 32,
                                              (const float*)(w + WS_FC) + (size_t)bh * SEQ, nullptr, 0.f, wsf, lane); }
                    }
                    __syncthreads();
                }
#endif
#ifdef DUP_FOX
                }
#endif
#endif
#if DYNQ
                {
                    PH_BEGIN();
                    volatile LAS unsigned* qslot = (volatile LAS unsigned*)((LAS unsigned char*)lds + 131072 + 320) + 13;
                    unsigned* qctr = (unsigned*)(w + WS_CTL) + 8192 + 64 * (2 + l);
                    const int first = l == 0 ? 0 : WPREP_W2D_FIRST / 8, count = l == 0 ? WPREP_W2D_FIRST / 8 : (WPREP_NIT - WPREP_W2D_FIRST) / 8;
                    unsigned char* dst = l == 0 ? (unsigned char*)GOUT + 64 * MiB : w + WS_W;
                    float* scr = (float*)(lds + wave * 16384);
#pragma unroll 1
                    for (;;) {
                        if (tid == 0) *qslot = __hip_atomic_fetch_add(qctr, 1u, __ATOMIC_RELAXED, __HIP_MEMORY_SCOPE_AGENT);
                        __syncthreads();
                        const int it = __builtin_amdgcn_readfirstlane((int)*qslot);
                        __syncthreads();
                        if (it >= count) break;
                        wprep_item(pp, 1, (first + it) * 8 + wave, dst, scr, lane);
                    }
                    __syncthreads();
                }
#endif
#if DYNQ
                {
                    PH_BEGIN();
                    float* btab = (float*)(lds + LDS_RS);
                    float* wsf = (float*)(lds + LDS_RS + 4096) + wave * 64;
                    for (int e = tid; e < 4 * 192; e += NTHR) { const int h = e / 192, dist = e % 192 - 32; float v = -1e30f;
                        if (dist >= 0 && dist < 128) { int bucket = dist;
                            if (dist >= 16) { bucket = 16 + (int)(logf((float)dist / 16.0f) / 2.0794415416798357f * 16.0f); bucket = bucket > 31 ? 31 : bucket; }
                            v = GIN(1)[bucket * 4 + h] * LOG2E; }
                        btab[e] = v; }
                    volatile LAS unsigned* qslot = (volatile LAS unsigned*)((LAS unsigned char*)lds + 131072 + 320) + 12;
                    unsigned* qctr = (unsigned*)(w + WS_CTL) + 8192 + 64 * l;
                    const bf16_t* r1 = (const bf16_t*)(w + WS_R1);
                    __syncthreads();
#pragma unroll 1
                    for (;;) {
                        if (tid == 0) *qslot = __hip_atomic_fetch_add(qctr, 1u, __ATOMIC_RELAXED, __HIP_MEMORY_SCOPE_AGENT);
                        __syncthreads();
                        const int it = __builtin_amdgcn_readfirstlane((int)*qslot);
                        __syncthreads();
                        if (it >= 512 + 512 + 256) break;
                        if (it < 512) {
                            conformer_unit(it, (const bf16_t*)(w + WS_R1 + R_U), GIN(9) + l * 31 * 256, GIN(10) + l * 256, GIN(11) + l * 256, GIN(12) + l * 256, (bf16_t*)GOUT  , lds, tid, wave, lane);
                        } else if (it < 1024) {
                            const int u = (it - 512) * 8 + wave, qblk = u & 255, hq = (u >> 8) & 3, b = u >> 10, kvh = hq >> 1;
                            attn_wave_unit<0>(r1 + R_AQ / 2 + (size_t)b * SEQ * 256 + hq * 64, 256, r1 + R_AK / 2 + (size_t)b * SEQ * 128 + kvh * 64, 128,
                                              r1 + R_AVT / 2 + (size_t)(b * 2 + kvh) * 64 * SEQ, (bf16_t*)GOUT + (size_t)2 * M * 256 + (size_t)b * SEQ * 256 + hq * 64, qblk * 32,
                                              nullptr, btab + hq * 192, GIN(18)[l * 4 + hq] * LOG2E, wsf, lane);
                        } else {
                            shortconv_all((const bf16_t*)(w + WS_R1 + R_SCX), (const bf16_t*)(w + WS_R1 + R_SB), GIN(14) + l * 3 * 256, (bf16_t*)GOUT + (size_t)M * 256  , (it - 1024) * NTHR + tid, (M / 8) * 32);
                        }
                    }
                }
#endif
                GRID_SYNC();
#ifndef SKIP_MERGE
#ifdef DUP_MERGE
#pragma unroll 1
                for (int rep_ = 0; rep_ < 2; ++rep_) {
#endif
#if MERGE_4PASS
#define MERGE_ONE(I) { PH_BEGIN(); pg8::StaticOrder S; S.init(M, D, G, bid); \
                    pg8::Gemm g{(const bf16_t*)(w + WS_XB) + (size_t)I * M * 256, (const bf16_t*)(w + WS_W + W_BR) + (size_t)I * 1024 * 256, M, D, 256}; \
                    pg8::EpiMerge<I> E{w}; pg8::gemm_phase<pg8::EpiMerge<I>, pg8::StaticOrder, true, true>(lds3, g, S, E, tid); }
                MERGE_ONE(0) MERGE_ONE(1) MERGE_ONE(2) MERGE_ONE(3)
#else
                {
                    PH_BEGIN();
                    pg8::MergeOrder S; S.base.init(M, D, G, bid);
                    pg8::Gemm g{(const bf16_t*)GOUT, (const bf16_t*)(WL_BASE + W_BR), 4 * M, 4 * D, 256};
                    pg8::EpiMergeH E{w};
                    pg8::gemm_phase<pg8::EpiMergeH, pg8::MergeOrder, true, true>(lds3, g, S, E, tid);
                }
#endif
#ifdef DUP_MERGE
                }
#endif
#endif
            }
            GRID_SYNC();
#ifndef SKIP_RESID
#ifdef DUP_RESID
#pragma unroll 1
            for (int rep_ = 0; rep_ < 2; ++rep_) {
            {
                PH_BEGIN();
                const bool last = (l == 1 && j == 2);
                const bf16_t* A = (const bf16_t*)(w + (j == 1 ? WS_R1 : WS_G));
                const bf16_t* Bt = (const bf16_t*)(j == 2 ? w + WS_W + W_2D : WL_BASE + (j == 0 ? W_1D : W_OUT));
                pg8::Gemm g{A, Bt, M, D, j == 1 ? D : DFF};
                pg8::StaticOrder S; S.init(M, D, G, bid);
                pg8::EpiResid E{(l == 0 && j == 0 && rep_ == 0) ? GIN(0) : GOUT, GOUT, last ? nullptr : (bf16_t*)(w + WS_XB), last ? nullptr : (float*)(w + WS_SSP), (j == 1 ? 1.0f : 0.5f) * 0.5f};
                pg8::gemm_phase<pg8::EpiResid, pg8::StaticOrder, true, true>(lds3, g, S, E, tid);
            }
            }
#else
            {
                PH_BEGIN();
                const bool last = (l == 1 && j == 2);
                const bf16_t* A = (const bf16_t*)(w + (j == 1 ? WS_R1 : WS_G));
                const bf16_t* Bt = (const bf16_t*)(j == 2 ? w + WS_W + W_2D : WL_BASE + (j == 0 ? W_1D : W_OUT));
                pg8::Gemm g{A, Bt, M, D, j == 1 ? D : DFF};
                pg8::StaticOrder S; S.init(M, D, G, bid);
                bf16_t* xbp = (bf16_t*)(w + WS_XB);
                pg8::EpiResid E{xbp, last ? nullptr : xbp, nullptr, last ? GOUT : nullptr, last ? nullptr : (float*)(w + WS_SSP), j == 1 ? 1.0f : 0.5f};
                pg8::gemm_phase<pg8::EpiResid, pg8::StaticOrder, true, true>(lds3, g, S, E, tid);
            }
#endif
#endif
            GRID_SYNC();
        }
    }
}

extern "C" void kernel_launch(void* const* d_in, const int* in_sizes, int n_in, void* d_out, int out_size, void* d_ws, size_t ws_size, hipStream_t stream) {
    static int grid = 0;
    if (grid == 0) {
        if (n_in != 28 || in_sizes[0] != M * D || out_size != M * D || ws_size < WS_END) { fprintf(stderr, "kernel_launch: unexpected shapes / workspace (n_in %d, ws %zu)\n", n_in, ws_size); grid = -1; return; }
        int dev = 0, cus = 0, per_cu = 0;
        if (hipGetDevice(&dev) != hipSuccess || hipDeviceGetAttribute(&cus, hipDeviceAttributeMultiprocessorCount, dev) != hipSuccess) { grid = -1; return; }
        if (hipFuncSetAttribute((const void*)fwd_kernel, hipFuncAttributeMaxDynamicSharedMemorySize, LDS_BYTES) != hipSuccess) { fprintf(stderr, "kernel_launch: hipFuncSetAttribute failed\n"); grid = -1; return; }
        if (hipOccupancyMaxActiveBlocksPerMultiprocessor(&per_cu, (const void*)fwd_kernel, NTHR, LDS_BYTES) != hipSuccess || per_cu < 1) { fprintf(stderr, "kernel_launch: occupancy query says %d\n", per_cu); per_cu = 1; }
        (void)hipGetLastError();
        grid = cus;
    }
    if (grid < 0) return;
    (void)hipMemsetAsync((char*)d_ws + WS_CTL, 0, CTL_ZERO_BYTES, stream);
    Params p{};
    for (int i = 0; i < 28; ++i) p.in[i] = (const float*)d_in[i];
    p.out = (float*)d_out; p.ws = (unsigned char*)d_ws;
    void* args[] = {&p};
    hipError_t e = hipLaunchCooperativeKernel((const void*)fwd_kernel, dim3(grid), dim3(NTHR), args, LDS_BYTES, stream);
    if (e != hipSuccess) fprintf(stderr, "kernel_launch: cooperative launch failed: %s\n", hipGetErrorString(e));
}
```
